# Optimizing an MI355X kernel written in HIP

```python
import math
import jax, jax.numpy as jnp
from jax import lax
import numpy as np

D_MODEL = 1024
BATCH = 4
SEQ = 4096
DEPTH = 2

N_MIXERS = 2
N_POOL_LAYERS = (DEPTH + 1) // 2
N_SSM_LAYERS = DEPTH // 2
RMS_EPS = 1e-5

POOL_WINDOWS = (2, 4, 8, 16)
N_POOL_GROUPS = len(POOL_WINDOWS)
POOL_GROUP = D_MODEL // N_POOL_GROUPS

SSM_EXPAND = 2
D_INNER = SSM_EXPAND * D_MODEL
HEAD_DIM = 64
N_HEADS = D_INNER // HEAD_DIM
N_GROUPS = 4
HEADS_PER_GROUP = N_HEADS // N_GROUPS
D_STATE = 128
CONV_K = 4
CHUNK = 128
CONV_DIM = D_INNER + 2 * N_GROUPS * D_STATE
IN_PROJ_DIM = D_INNER + CONV_DIM + N_HEADS

D_FF = 4 * D_MODEL

kernel_name = "pool_ssd_interleaved_hybrid"


def rms_norm(x, g):
    xf = x.astype(jnp.float32)
    y = xf * lax.rsqrt(jnp.mean(xf * xf, axis=-1, keepdims=True) + RMS_EPS)
    return (y * g.astype(jnp.float32)).astype(x.dtype)


def pool_mixer(h, w_pool, b_pool, scale):
    b, s, d = h.shape
    hf = h.astype(jnp.float32)
    cs = jnp.pad(jnp.cumsum(hf, axis=1), ((0, 0), (1, 0), (0, 0)))
    t = jnp.arange(s)
    hg = hf.reshape(b, s, N_POOL_GROUPS, POOL_GROUP)
    csg = cs.reshape(b, s + 1, N_POOL_GROUPS, POOL_GROUP)
    pooled = []
    for gi, w in enumerate(POOL_WINDOWS):
        c = csg[:, :, gi]
        lower = c[:, jnp.maximum(t + 1 - w, 0)]
        count = jnp.minimum(t + 1, w).astype(jnp.float32)
        pooled.append((c[:, 1:] - lower) / count[None, :, None])
    mixed = jnp.stack(pooled, axis=2) - hg
    out = jnp.einsum("bsgi,gio->bsgo", mixed, w_pool.astype(jnp.float32)).reshape(b, s, d)
    out = (out + b_pool.astype(jnp.float32)) * scale.astype(jnp.float32)
    return out.astype(h.dtype)


def causal_dwconv(u, w, bias):
    s = u.shape[1]
    up = jnp.pad(u, ((0, 0), (CONV_K - 1, 0), (0, 0)))
    out = up[:, 0:s] * w[0]
    for k in range(1, CONV_K):
        out = out + up[:, k:k + s] * w[k]
    return out + bias


def ssd_scan(xs, dt, a, bm, cm):
    b, s, g, r, p = xs.shape
    n = bm.shape[-1]
    nc = s // CHUNK
    x = xs.astype(jnp.float32).reshape(b, nc, CHUNK, g, r, p)
    dtc = dt.astype(jnp.float32).reshape(b, nc, CHUNK, g, r)
    bc = bm.astype(jnp.float32).reshape(b, nc, CHUNK, g, n)
    cc = cm.astype(jnp.float32).reshape(b, nc, CHUNK, g, n)
    xdt = x * dtc[..., None]
    adt = jnp.moveaxis(dtc * a.astype(jnp.float32), 2, -1)
    a_cs = jnp.cumsum(adt, axis=-1)
    causal = jnp.tril(jnp.ones((CHUNK, CHUNK), dtype=bool))
    seg = a_cs[..., :, None] - a_cs[..., None, :]
    decay = jnp.exp(jnp.where(causal, seg, -jnp.inf))
    cb = jnp.einsum("bclgn,bcsgn->bcgls", cc, bc)
    y_diag = jnp.einsum("bcgls,bcgrls,bcsgrp->bclgrp", cb, decay, xdt)
    decay_to_end = jnp.exp(a_cs[..., -1:] - a_cs)
    states = jnp.einsum("bclgn,bcgrl,bclgrp->bcgrpn", bc, decay_to_end, xdt)
    chunk_decay = jnp.exp(a_cs[..., -1])

    def step(hstate, inp):
        st, dec = inp
        return hstate * dec[..., None, None] + st, hstate

    h0 = jnp.zeros((b, g, r, p, n), jnp.float32)
    _, prev = lax.scan(step, h0, (jnp.moveaxis(states, 1, 0), jnp.moveaxis(chunk_decay, 1, 0)))
    prev = jnp.moveaxis(prev, 0, 1)
    y_off = jnp.einsum("bclgn,bcgrpn,bcgrl->bclgrp", cc, prev, jnp.exp(a_cs))
    return (y_diag + y_off).reshape(b, s, g, r, p)


def ssd_mixer(h, w_in, conv_w, conv_b, dt_bias, a_log, d_skip, norm_g, w_out):
    b, s, _ = h.shape
    zxbcdt = h @ w_in
    z = zxbcdt[..., :D_INNER]
    xbc = zxbcdt[..., D_INNER:D_INNER + CONV_DIM]
    dt_raw = zxbcdt[..., D_INNER + CONV_DIM:]
    xbc = jax.nn.silu(causal_dwconv(xbc, conv_w, conv_b))
    xs = xbc[..., :D_INNER].reshape(b, s, N_GROUPS, HEADS_PER_GROUP, HEAD_DIM)
    bm = xbc[..., D_INNER:D_INNER + N_GROUPS * D_STATE].reshape(b, s, N_GROUPS, D_STATE)
    cm = xbc[..., D_INNER + N_GROUPS * D_STATE:].reshape(b, s, N_GROUPS, D_STATE)
    dt = jax.nn.softplus(dt_raw.astype(jnp.float32) + dt_bias.astype(jnp.float32))
    dt = dt.reshape(b, s, N_GROUPS, HEADS_PER_GROUP)
    a = -jnp.exp(a_log.astype(jnp.float32)).reshape(N_GROUPS, HEADS_PER_GROUP)
    y = ssd_scan(xs, dt, a, bm, cm)
    y = y + d_skip.astype(jnp.float32).reshape(N_GROUPS, HEADS_PER_GROUP)[..., None] * xs.astype(jnp.float32)
    y = y.reshape(b, s, D_INNER) * jax.nn.silu(z.astype(jnp.float32))
    yg = y.reshape(b, s, N_GROUPS, D_INNER // N_GROUPS)
    yg = yg * lax.rsqrt(jnp.mean(yg * yg, axis=-1, keepdims=True) + RMS_EPS)
    y = (yg.reshape(b, s, D_INNER) * norm_g.astype(jnp.float32)).astype(h.dtype)
    return y @ w_out


def sq_relu_mlp(h, w1, w2):
    u = jax.nn.relu(h @ w1)
    return (u * u) @ w2


def setup_inputs(seed: int = 0) -> dict:
    key = jax.random.key(seed)
    ks = jax.random.split(key, 20)
    f32 = jnp.float32
    nrm = lambda k, shape, scale: jax.random.normal(k, shape, f32) * scale
    x = jax.random.normal(ks[0], (BATCH, SEQ, D_MODEL), f32)
    norm_mix_g = 1.0 + nrm(ks[1], (DEPTH, D_MODEL), 0.05)
    norm_mlp_g = 1.0 + nrm(ks[2], (DEPTH, D_MODEL), 0.05)
    pool_w = nrm(ks[3], (N_POOL_LAYERS, N_POOL_GROUPS, POOL_GROUP, POOL_GROUP), POOL_GROUP ** -0.5)
    pool_b = nrm(ks[4], (N_POOL_LAYERS, D_MODEL), 0.02)
    pool_scale = 0.5 + nrm(ks[5], (N_POOL_LAYERS, D_MODEL), 0.05)
    ssm_w_in = nrm(ks[6], (N_SSM_LAYERS, D_MODEL, IN_PROJ_DIM), D_MODEL ** -0.5)
    ssm_conv_w = nrm(ks[7], (N_SSM_LAYERS, CONV_K, CONV_DIM), CONV_K ** -0.5)
    ssm_conv_b = nrm(ks[8], (N_SSM_LAYERS, CONV_DIM), 0.02)
    dt0 = jnp.exp(jax.random.uniform(ks[9], (N_SSM_LAYERS, N_HEADS), f32)
                  * (math.log(0.1) - math.log(0.001)) + math.log(0.001))
    ssm_dt_bias = dt0 + jnp.log(-jnp.expm1(-dt0))
    ssm_a_log = jnp.log(jax.random.uniform(ks[10], (N_SSM_LAYERS, N_HEADS), f32, 1.0, 16.0))
    ssm_d = 1.0 + nrm(ks[11], (N_SSM_LAYERS, N_HEADS), 0.1)
    ssm_norm_g = 1.0 + nrm(ks[12], (N_SSM_LAYERS, D_INNER), 0.05)
    ssm_w_out = nrm(ks[13], (N_SSM_LAYERS, D_INNER, D_MODEL), D_INNER ** -0.5)
    mlp_w1 = nrm(ks[14], (DEPTH, D_MODEL, D_FF), D_MODEL ** -0.5)
    mlp_w2 = nrm(ks[15], (DEPTH, D_FF, D_MODEL), D_FF ** -0.5)
    final_g = 1.0 + nrm(ks[16], (D_MODEL,), 0.05)
    return {"x": x, "norm_mix_g": norm_mix_g, "norm_mlp_g": norm_mlp_g,
            "pool_w": pool_w, "pool_b": pool_b, "pool_scale": pool_scale,
            "ssm_w_in": ssm_w_in, "ssm_conv_w": ssm_conv_w, "ssm_conv_b": ssm_conv_b,
            "ssm_dt_bias": ssm_dt_bias, "ssm_a_log": ssm_a_log, "ssm_d": ssm_d,
            "ssm_norm_g": ssm_norm_g, "ssm_w_out": ssm_w_out,
            "mlp_w1": mlp_w1, "mlp_w2": mlp_w2, "final_g": final_g}


def reference(x, norm_mix_g, norm_mlp_g, pool_w, pool_b, pool_scale,
              ssm_w_in, ssm_conv_w, ssm_conv_b, ssm_dt_bias, ssm_a_log, ssm_d,
              ssm_norm_g, ssm_w_out, mlp_w1, mlp_w2, final_g):
    h = x
    for i in range(DEPTH):
        hn = rms_norm(h, norm_mix_g[i])
        if i % N_MIXERS == 0:
            j = i // N_MIXERS
            mix = pool_mixer(hn, pool_w[j], pool_b[j], pool_scale[j])
        else:
            j = i // N_MIXERS
            mix = ssd_mixer(hn, ssm_w_in[j], ssm_conv_w[j], ssm_conv_b[j], ssm_dt_bias[j],
                            ssm_a_log[j], ssm_d[j], ssm_norm_g[j], ssm_w_out[j])
        h = h + mix
        h = h + sq_relu_mlp(rms_norm(h, norm_mlp_g[i]), mlp_w1[i], mlp_w2[i])
    return rms_norm(h, final_g)
```

```cpp
#include <hip/hip_runtime.h>
#include <hip/hip_cooperative_groups.h>
#include <cstdio>
#include <cstdint>
namespace cg = cooperative_groups;

#ifndef MK_PHASE_MASK
#define MK_PHASE_MASK 0xFFF
#endif
#ifndef MK_PER_PHASE
#define MK_PER_PHASE 0
#endif

#define LAS __attribute__((address_space(3)))
typedef unsigned short bf16_t;
typedef short bf16x8 __attribute__((ext_vector_type(8)));
typedef float f32x4 __attribute__((ext_vector_type(4)));
typedef unsigned u32x4 __attribute__((ext_vector_type(4)));
typedef unsigned u32x2 __attribute__((ext_vector_type(2)));

constexpr int M = 16384, D = 1024, FF = 4096, DI = 2048, NH = 32, SEQ = 4096, INP = 5152, NMAIN = 5120;
constexpr float EPS = 1e-5f;
constexpr size_t MiB = 1u << 20;
constexpr size_t WS_SSQ = 0;
constexpr size_t WS_DT = 1 * MiB;
constexpr size_t WS_ACS = 3 * MiB;
constexpr size_t WS_BAR = 7 * MiB;
constexpr size_t WS_W = 8 * MiB;
constexpr size_t W_POOL = WS_W, W_W1_0 = WS_W + 1 * MiB, W_W2_0 = WS_W + 9 * MiB, W_IN = WS_W + 17 * MiB, W_OUT = WS_W + 28 * MiB, W_W1_1 = WS_W + 32 * MiB, W_W2_1 = WS_W + 40 * MiB;
constexpr size_t WS_CB = W_W1_0;
constexpr size_t WS_HB = 56 * MiB;
constexpr size_t WS_U = 88 * MiB;
constexpr size_t WS_MIXED = WS_U;
constexpr size_t WS_RAWX = 88 * MiB;
constexpr size_t WS_RAWBC = 152 * MiB;
constexpr size_t WS_ZS = 184 * MiB;
constexpr size_t WS_END = 248 * MiB;

__host__ __device__ constexpr size_t dti(int row, int h) { return ((size_t)(row >> 7) * 32 + h) * 128 + (row & 127); }
constexpr int LDS_BYTES = 147456, LDS_BARST = 139264;

typedef float f32x2_t __attribute__((ext_vector_type(2)));
typedef __bf16 bf16x2_t __attribute__((ext_vector_type(2)));
__device__ __forceinline__ unsigned pk2(float lo, float hi) { f32x2_t v = {lo, hi}; bf16x2_t b = __builtin_convertvector(v, bf16x2_t); return __builtin_bit_cast(unsigned, b); }
__device__ __forceinline__ int lane_id_opaque() { int l; asm volatile("v_mbcnt_lo_u32_b32 %0, -1, 0\n\tv_mbcnt_hi_u32_b32 %0, -1, %0" : "=v"(l)); return l; }
__device__ __forceinline__ void lds_barrier() { asm volatile("s_waitcnt lgkmcnt(0)\n\ts_barrier" ::: "memory"); }
__device__ __forceinline__ u32x4 widen16(u32x2 a, u32x2 b) {
    const auto r0 = __builtin_amdgcn_permlane16_swap(a.x, b.x, false, false); const auto r1 = __builtin_amdgcn_permlane16_swap(a.y, b.y, false, false);
    return (u32x4){r0[0], r1[0], r0[1], r1[1]}; }
__device__ __forceinline__ void unwiden16(u32x4 v, u32x2& a, u32x2& b) {
    const auto r0 = __builtin_amdgcn_permlane16_swap(v.x, v.z, false, false); const auto r1 = __builtin_amdgcn_permlane16_swap(v.y, v.w, false, false);
    a = (u32x2){r0[0], r1[0]}; b = (u32x2){r0[1], r1[1]}; }
#define WSEL(k, q) ((k) + ((q) & 1))
#define WOFF(q) (((q) & ~1) * 4)
__device__ __forceinline__ float bflo(unsigned u) { return __builtin_bit_cast(float, u << 16); }
__device__ __forceinline__ float bfhi(unsigned u) { return __builtin_bit_cast(float, u & 0xffff0000u); }
__device__ __forceinline__ float bf2f(bf16_t b) { return __builtin_bit_cast(float, (unsigned)b << 16); }
__device__ __forceinline__ bf16_t f2bf(float f) { return (bf16_t)(pk2(f, 0.f) & 0xffffu); }
__device__ __forceinline__ float siluf(float v) { return v * __builtin_amdgcn_rcpf(1.f + __expf(-v)); }
__device__ __forceinline__ f32x4 mfma16(bf16x8 a, bf16x8 b, f32x4 c) { return __builtin_amdgcn_mfma_f32_16x16x32_bf16(a, b, c, 0, 0, 0); }
__device__ __forceinline__ float wave_sum(float v) {
#pragma unroll
    for (int o = 1; o < 64; o <<= 1) v += __shfl_xor(v, o);
    return v;
}
__device__ __forceinline__ float rstd_from_ssq(const float* ssq, int row) {
    const f32x4* p = (const f32x4*)(ssq + (size_t)row * 16);
    const f32x4 a = p[0], b = p[1], c = p[2], d = p[3];
    const float s = ((a.x + a.y) + (a.z + a.w)) + ((b.x + b.y) + (b.z + b.w)) + ((c.x + c.y) + (c.z + c.w)) + ((d.x + d.y) + (d.z + d.w));
    return rsqrtf(s * (1.f / D) + EPS);
}


typedef __amdgpu_buffer_rsrc_t rsrc_t;
__device__ __forceinline__ rsrc_t ws_rsrc(const void* base) { return __builtin_amdgcn_make_buffer_rsrc((void*)base, (short)0, 0x10000000, 0x00020000); }
__device__ __forceinline__ void st16_wt_nt(rsrc_t r, size_t byte_off, u32x4 v) { __builtin_amdgcn_raw_buffer_store_b128(v, r, (unsigned)byte_off, 0,   18); }
__device__ __forceinline__ void st16_wt(rsrc_t r, size_t byte_off, u32x4 v) { __builtin_amdgcn_raw_buffer_store_b128(v, r, (unsigned)byte_off, 0,   16); }

#define XB_TMO      128
#define XB_XCNT(j)  (256  + 64 * (j))
#define XB_XSUB(j)  (1280 + 64 * (j))
#define XB_XGEN(j)  (2304 + 64 * (j))
#define XB_TOP      3328
#define XB_TOPGEN   3392
#define XCD_BAR_WORDS 3456
#define XB_SPIN_CAP (1u << 18)
__device__ __forceinline__ unsigned xb_ld(unsigned* p)              { return __hip_atomic_load(p, __ATOMIC_RELAXED, __HIP_MEMORY_SCOPE_AGENT); }
__device__ __forceinline__ unsigned xb_add(unsigned* p, unsigned v) { return __hip_atomic_fetch_add(p, v, __ATOMIC_RELAXED, __HIP_MEMORY_SCOPE_AGENT); }
__device__ __forceinline__ unsigned xb_xcc_id() { return (unsigned)__builtin_amdgcn_s_getreg((3 << 11) | 20) & 0xFu; }
#define XB_SPIN(cond, bar) do { unsigned _sp = 0; while (cond) { __builtin_amdgcn_s_sleep(1); \
    if ((++_sp & 255u) == 0u) { if (xb_ld(&(bar)[XB_TMO])) break; if (_sp > XB_SPIN_CAP) { atomicAdd(&(bar)[XB_TMO], 1u); break; } } } } while (0)
struct XcdBarrier { unsigned* bar; unsigned x; volatile LAS unsigned* st; };
__device__ __forceinline__ XcdBarrier xcd_barrier_post(unsigned* bar, volatile LAS unsigned* st) {
    XcdBarrier b; b.bar = bar; b.x = xb_xcc_id(); b.st = st;
    if (threadIdx.x == 0) (void)xb_add(&bar[XB_XCNT(b.x)], 1u);
    return b;
}
__device__ __forceinline__ void xcd_barrier_complete(unsigned* bar, unsigned x, unsigned& nloc, unsigned& nx) {
    const unsigned G = gridDim.x * gridDim.y * gridDim.z;
    unsigned sum, cnt, mine, sp = 0u;
    for (;;) {
        sum = 0u; cnt = 0u; mine = 0u;
#pragma unroll
        for (unsigned j = 0; j < 16; ++j) { const unsigned c = xb_ld(&bar[XB_XCNT(j)]); sum += c; cnt += (c > 0u) ? 1u : 0u; mine = (j == x) ? c : mine; }
        if (sum == G) break;
        __builtin_amdgcn_s_sleep(1);
        if ((++sp & 255u) == 0u) { if (xb_ld(&bar[XB_TMO])) break; if (sp > XB_SPIN_CAP) { atomicAdd(&bar[XB_TMO], 1u); break; } }
    }
    nloc = mine > 0u ? mine : 1u; nx = cnt > 0u ? cnt : 1u;
}
__device__ __forceinline__ void xcd_barrier(const XcdBarrier& b, const bool leader) {
    asm volatile("s_waitcnt vmcnt(0)" ::: "memory");
    __syncthreads();
    if (leader) {
        unsigned* bar = b.bar;
        __builtin_amdgcn_s_waitcnt(0);
        unsigned nloc = b.st[0], nx = b.st[1];
        if (nloc == 0u) { xcd_barrier_complete(bar, b.x, nloc, nx); b.st[0] = nloc; b.st[1] = nx; }
        const unsigned old = xb_add(&bar[XB_XSUB(b.x)], 1u);
        const unsigned gen = old / nloc;
        if (old + 1u == (gen + 1u) * nloc) {
            __builtin_amdgcn_fence(__ATOMIC_RELEASE, "agent");
            asm volatile("s_waitcnt vmcnt(0)" ::: "memory");
            const unsigned og = xb_add(&bar[XB_TOP], 1u);
            const unsigned tg = og / nx;
            if (og + 1u == (tg + 1u) * nx) xb_add(&bar[XB_TOPGEN], 1u);
            else XB_SPIN(xb_ld(&bar[XB_TOPGEN]) == tg, bar);
            __builtin_amdgcn_fence(__ATOMIC_ACQUIRE, "agent");
            xb_add(&bar[XB_XGEN(b.x)], 1u);
            asm volatile("s_waitcnt vmcnt(0)" ::: "memory");
        } else {
            XB_SPIN(xb_ld(&bar[XB_XGEN(b.x)]) == gen, bar);
            __builtin_amdgcn_fence(__ATOMIC_ACQUIRE, "agent");
            asm volatile("s_waitcnt vmcnt(0)" ::: "memory");
        }
    }
    __syncthreads();
}

namespace pg8 {
constexpr int BM = 256, BK = 64, HALF = 128, HTB = HALF * BK * 2, NXCD = 8, WGM = 4;
__host__ __device__ __forceinline__ int lds_byte(int r, int c) { const int st = (r >> 4) * 2 + (c >> 5), rr = r & 15, cc = c & 31, ob = rr * 64 + cc * 2; return st * 1024 + (ob ^ (((ob >> 9) & 1) << 5)); }
__host__ __device__ __forceinline__ void stage_rc(int b, int& R, int& C) { const int st = b / 1024, sb = b % 1024, swz = sb ^ (((sb >> 9) & 1) << 5); R = (st >> 1) * 16 + swz / 64; C = (st & 1) * 32 + (swz % 64) / 2; }
__host__ __device__ __forceinline__ int perm32(int rho) { const int n = rho >> 4, i = rho & 15; return 8 * (i >> 2) + 4 * n + (i & 3); }

struct Unit { int pm, pn; };
struct Gemm { const bf16_t* A; const bf16_t* Bt; int M, N, K, lda, a_pn_off; };

struct StaticOrder {
    int nM, nN, nwg, G, c;
    __host__ __device__ void init(int M_, int N_, int G_, int c_) { nM = M_ / BM; nN = N_ / BM; nwg = nM * nN; G = G_; c = c_; }
    __host__ __device__ bool next(int i, Unit& u) const {
        const long L = (long)i * G + c; if (L >= nwg) return false;
        int wgid = (int)L; { const int q = nwg / NXCD, r = nwg % NXCD, xcd = wgid % NXCD, off = wgid / NXCD; wgid = (xcd < r ? xcd * (q + 1) : r * (q + 1) + (xcd - r) * q) + off; }
        const int nig = WGM * nN, gid = wgid / nig, fm = gid * WGM, gsz = (nM - fm) < WGM ? (nM - fm) : WGM;
        u.pm = fm + ((wgid % nig) % gsz); u.pn = (wgid % nig) / gsz; return true;
    }
};

template <class Epi, bool ALIGN_EPI>
__device__ __forceinline__ void gemm_phase(LAS unsigned char* lds, const Gemm g, const StaticOrder& S, const Epi& E, const int wid) {
    const int lane = lane_id_opaque(), tid = wid * 64 + lane, wr = wid >> 2, wc = wid & 3, fr = lane & 15, fq = lane >> 4;
    const int K = g.K, nt = K / BK;
    unsigned voffA[2], voffB[2];
#pragma unroll
    for (int i = 0; i < 2; ++i) { int R, C; stage_rc(tid * 16 + i * 8192, R, C); const int Rb = (R & ~31) + perm32(R & 31);
        voffA[i] = (unsigned)(R * g.lda + C) * 2u; voffB[i] = (unsigned)(Rb * K + C) * 2u; }
    const size_t kstep = (size_t)(BK * 2);
    const size_t hstepA = (size_t)HALF * g.lda * 2, hstepB = (size_t)HALF * K * 2;
    const size_t tstepA = 2 * hstepA, tstepB = 2 * hstepB;
    const unsigned ldsw = (unsigned)wid * 1024u;
    const int aoff = lds_byte(wr * 64 + fr, fq * 8), boff = lds_byte(wc * 32 + fr, fq * 8);
#define PG8_SA(b, h) (((b) * 2 + (h)) * HTB)
#define PG8_SB(b, h) ((4 + (b) * 2 + (h)) * HTB)
#define PG8_STAGE(bufoff, gbase, voff) do { _Pragma("unroll") for (int _i = 0; _i < 2; ++_i) \
        __builtin_amdgcn_global_load_lds((const unsigned*)((const char*)(gbase) + (voff)[_i]), (LAS unsigned*)(lds + (bufoff) + ldsw + _i * 8192), 16, 0, 0); } while (0)
#define PG8_LDA(dst, b, h) do { _Pragma("unroll") for (int m = 0; m < 4; ++m) _Pragma("unroll") for (int k = 0; k < 2; ++k) dst[m][k] = *(const LAS bf16x8*)(lds + PG8_SA(b, h) + aoff + m * 2048 + k * 1024); } while (0)
#define PG8_LDB(dst, b, h) do { _Pragma("unroll") for (int n = 0; n < 2; ++n) _Pragma("unroll") for (int k = 0; k < 2; ++k) dst[n][k] = *(const LAS bf16x8*)(lds + PG8_SB(b, h) + boff + n * 2048 + k * 1024); } while (0)
#define PG8_MMA(ai, bj, At, Bt) do { __builtin_amdgcn_s_setprio(1); _Pragma("unroll") for (int m = 0; m < 4; ++m) _Pragma("unroll") for (int n = 0; n < 2; ++n) _Pragma("unroll") for (int k = 0; k < 2; ++k) \
        acc[ai][bj][m][n] = __builtin_amdgcn_mfma_f32_16x16x32_bf16(Bt[n][k], At[m][k], acc[ai][bj][m][n], 0, 0, 0); __builtin_amdgcn_s_setprio(0); } while (0)
#define PG8_WAIT_V(n) asm volatile("s_waitcnt vmcnt(" #n ")" ::: "memory")
#define PG8_WAIT_L(n) asm volatile("s_waitcnt lgkmcnt(" #n ")" ::: "memory")
#define PG8_BAR __builtin_amdgcn_s_barrier()
#define PG8_SCHED __builtin_amdgcn_sched_barrier(0)
    Unit cur, nxt; int ui = 0;
    if (!S.next(0, cur)) return;
    f32x4 acc[2][2][4][2];
#pragma unroll
    for (int a = 0; a < 2; ++a)
#pragma unroll
        for (int b = 0; b < 2; ++b)
#pragma unroll
            for (int m = 0; m < 4; ++m)
#pragma unroll
                for (int n = 0; n < 2; ++n) acc[a][b][m][n] = (f32x4){0.f, 0.f, 0.f, 0.f};
    bf16x8 At[4][2], B0[2][2], B1[2][2];
    const char* cA = (const char*)g.A + (size_t)cur.pm * tstepA + (size_t)cur.pn * g.a_pn_off * 2; const char* cB = (const char*)g.Bt + (size_t)cur.pn * tstepB;
    PG8_STAGE(PG8_SB(0, 0), cB, voffB); PG8_STAGE(PG8_SB(0, 1), cB + hstepB, voffB); PG8_STAGE(PG8_SA(0, 0), cA, voffA); PG8_STAGE(PG8_SA(0, 1), cA + hstepA, voffA);
    if (wr == 1) PG8_BAR;
    PG8_WAIT_V(2); PG8_BAR;
    PG8_STAGE(PG8_SB(1, 0), cB + kstep, voffB); PG8_STAGE(PG8_SA(1, 0), cA + kstep, voffA); PG8_STAGE(PG8_SB(1, 1), cB + hstepB + kstep, voffB);
    PG8_WAIT_V(6); PG8_BAR;
    for (;;) {
        const bool has_next = S.next(ui + 1, nxt);
        const char* nA = has_next ? (const char*)g.A + (size_t)nxt.pm * tstepA + (size_t)nxt.pn * g.a_pn_off * 2 : cA; const char* nB = has_next ? (const char*)g.Bt + (size_t)nxt.pn * tstepB : cB;
        for (int t = 0; t < nt; t += 2) {
            const bool last = (t == nt - 2);
            const char* a1 = cA + (size_t)(t + 1) * kstep;
            const char* a2 = last ? nA : cA + (size_t)(t + 2) * kstep; const char* b2 = last ? nB : cB + (size_t)(t + 2) * kstep;
            const char* a3 = a2 + kstep; const char* b3 = b2 + kstep;
            PG8_LDB(B0, 0, 0); PG8_LDB(B1, 0, 1); PG8_SCHED; PG8_LDA(At, 0, 0); PG8_STAGE(PG8_SA(1, 1), a1 + hstepA, voffA);
            PG8_WAIT_V(8); PG8_WAIT_L(0); PG8_BAR; PG8_MMA(0, 0, At, B0); PG8_MMA(0, 1, At, B1); PG8_BAR; PG8_SCHED;
            PG8_LDA(At, 0, 1); PG8_STAGE(PG8_SB(0, 0), b2, voffB); PG8_STAGE(PG8_SB(0, 1), b2 + hstepB, voffB); PG8_STAGE(PG8_SA(0, 0), a2, voffA);
            PG8_WAIT_V(8); PG8_WAIT_L(0); PG8_BAR; PG8_MMA(1, 0, At, B0); PG8_MMA(1, 1, At, B1); PG8_BAR; PG8_SCHED;
            PG8_LDB(B0, 1, 0); PG8_LDB(B1, 1, 1); PG8_SCHED; PG8_LDA(At, 1, 0); PG8_STAGE(PG8_SA(0, 1), a2 + hstepA, voffA);
            PG8_WAIT_V(8); PG8_WAIT_L(0); PG8_BAR; PG8_MMA(0, 0, At, B0); PG8_MMA(0, 1, At, B1); PG8_BAR; PG8_SCHED;
            PG8_LDA(At, 1, 1); PG8_STAGE(PG8_SB(1, 0), b3, voffB); PG8_STAGE(PG8_SB(1, 1), b3 + hstepB, voffB); PG8_STAGE(PG8_SA(1, 0), a3, voffA);
            PG8_WAIT_V(8); PG8_WAIT_L(0); PG8_BAR; PG8_MMA(1, 0, At, B0); PG8_MMA(1, 1, At, B1); PG8_BAR; PG8_SCHED;
        }
        if constexpr (ALIGN_EPI) { if (wr == 0) PG8_BAR; }
        E(acc, cur, wr, wc, fr, fq);
        if (!has_next) break;
#pragma unroll
        for (int a = 0; a < 2; ++a)
#pragma unroll
            for (int b = 0; b < 2; ++b)
#pragma unroll
                for (int m = 0; m < 4; ++m)
#pragma unroll
                    for (int n = 0; n < 2; ++n) acc[a][b][m][n] = (f32x4){0.f, 0.f, 0.f, 0.f};
        cur = nxt; cA = nA; cB = nB; ++ui;
        if constexpr (ALIGN_EPI) { if (wr == 1) PG8_BAR; }
    }
    PG8_WAIT_V(0);
    if constexpr (!ALIGN_EPI) { if (wr == 0) PG8_BAR; }
    PG8_BAR;
#undef PG8_SA
#undef PG8_SB
#undef PG8_STAGE
#undef PG8_LDA
#undef PG8_LDB
#undef PG8_MMA
#undef PG8_WAIT_V
#undef PG8_WAIT_L
#undef PG8_BAR
#undef PG8_SCHED
}

typedef f32x4 Acc[2][2][4][2];

__device__ __forceinline__ void rstd8(const float* ssq, int row0, int fq, float (&rs)[8]) {
    f32x4 part[8];
#pragma unroll
    for (int i = 0; i < 8; ++i) part[i] = *(const f32x4*)(ssq + (size_t)(row0 + (i >> 2) * HALF + (i & 3) * 16) * 16 + fq * 4);
#pragma unroll
    for (int i = 0; i < 8; ++i) { float t = (part[i].x + part[i].y) + (part[i].z + part[i].w); t += __shfl_xor(t, 16); t += __shfl_xor(t, 32); rs[i] = rsqrtf(t * (1.f / D) + EPS); }
}

__device__ __forceinline__ void put_ssq(float* ssq, int row, int pn, int wc, int fq, float ss) {
    ss += __shfl_xor(ss, 16); ss += __shfl_xor(ss, 32);
    if (fq == 0) ssq[(size_t)row * 16 + pn * 4 + wc] = ss;
}

struct EpiPool {
    const float* x; bf16_t* hb; const float* bias; const float* scale; float* ssq;
    __device__ __forceinline__ void operator()(const Acc& acc, const Unit& u, int wr, int wc, int fr, int fq) const {
        const int row0 = u.pm * BM + wr * 64 + fr, col0 = u.pn * BM + wc * 32 + 8 * fq;
#pragma unroll
        for (int ai = 0; ai < 2; ++ai) { f32x4 xq[4][2][2];
#pragma unroll
            for (int m = 0; m < 4; ++m)
#pragma unroll
                for (int bj = 0; bj < 2; ++bj) { const size_t o = (size_t)(row0 + ai * HALF + m * 16) * D + col0 + bj * HALF; xq[m][bj][0] = __builtin_nontemporal_load((const f32x4*)(x + o)); xq[m][bj][1] = __builtin_nontemporal_load((const f32x4*)(x + o + 4)); }
#pragma unroll
            for (int m = 0; m < 4; ++m) { const int row = row0 + ai * HALF + m * 16; float ss = 0.f;
#pragma unroll
                for (int bj = 0; bj < 2; ++bj) { const int c = col0 + bj * HALF; const size_t o = (size_t)row * D + c;
                    const f32x4 x0 = xq[m][bj][0], x1 = xq[m][bj][1];
                    const f32x4 b0 = *(const f32x4*)(bias + c), b1 = *(const f32x4*)(bias + c + 4), s0 = *(const f32x4*)(scale + c), s1 = *(const f32x4*)(scale + c + 4);
                    const f32x4 v0 = x0 + (acc[ai][bj][m][0] + b0) * s0, v1 = x1 + (acc[ai][bj][m][1] + b1) * s1;
                    u32x4 w; w.x = pk2(v0[0], v0[1]); w.y = pk2(v0[2], v0[3]); w.z = pk2(v1[0], v1[1]); w.w = pk2(v1[2], v1[3]);
                    st16_wt(ws_rsrc(hb), o * 2, w);
                    ss += (v0[0] * v0[0] + v0[1] * v0[1]) + (v0[2] * v0[2] + v0[3] * v0[3]) + (v1[0] * v1[0] + v1[1] * v1[1]) + (v1[2] * v1[2] + v1[3] * v1[3]); }
                put_ssq(ssq, row, u.pn, wc, fq, ss); } }
    }
};
struct EpiRes {
    bf16_t* hb; float* ssq;
    __device__ __forceinline__ void operator()(const Acc& acc, const Unit& u, int wr, int wc, int fr, int fq) const {
        const int row0 = u.pm * BM + wr * 64 + fr, col0 = u.pn * BM + wc * 32 + 8 * fq;
        u32x4 hq[2][4][2];
#pragma unroll
        for (int ai = 0; ai < 2; ++ai)
#pragma unroll
            for (int m = 0; m < 4; ++m)
#pragma unroll
                for (int bj = 0; bj < 2; ++bj) hq[ai][m][bj] = *(const u32x4*)(hb + (size_t)(row0 + ai * HALF + m * 16) * D + col0 + bj * HALF);
#pragma unroll
        for (int ai = 0; ai < 2; ++ai)
#pragma unroll
            for (int m = 0; m < 4; ++m) { const int row = row0 + ai * HALF + m * 16; float ss = 0.f;
#pragma unroll
                for (int bj = 0; bj < 2; ++bj) { const size_t o = (size_t)row * D + col0 + bj * HALF;
                    const u32x4 hv = hq[ai][m][bj];
                    const f32x4 v0 = (f32x4){bflo(hv.x), bfhi(hv.x), bflo(hv.y), bfhi(hv.y)} + acc[ai][bj][m][0], v1 = (f32x4){bflo(hv.z), bfhi(hv.z), bflo(hv.w), bfhi(hv.w)} + acc[ai][bj][m][1];
                    u32x4 w; w.x = pk2(v0[0], v0[1]); w.y = pk2(v0[2], v0[3]); w.z = pk2(v1[0], v1[1]); w.w = pk2(v1[2], v1[3]);
                    st16_wt(ws_rsrc(hb), o * 2, w);
                    ss += (v0[0] * v0[0] + v0[1] * v0[1]) + (v0[2] * v0[2] + v0[3] * v0[3]) + (v1[0] * v1[0] + v1[1] * v1[1]) + (v1[2] * v1[2] + v1[3] * v1[3]); }
                put_ssq(ssq, row, u.pn, wc, fq, ss); }
    }
};
struct EpiUp {
    bf16_t* U; const float* ssq;
    __device__ __forceinline__ void operator()(const Acc& acc, const Unit& u, int wr, int wc, int fr, int fq) const {
        const int row0 = u.pm * BM + wr * 64 + fr, col0 = u.pn * BM + wc * 32 + 8 * fq;
        float rs8[8]; rstd8(ssq, row0, fq, rs8);
#pragma unroll
        for (int ai = 0; ai < 2; ++ai)
#pragma unroll
            for (int m = 0; m < 4; ++m) { const int row = row0 + ai * HALF + m * 16; const float rs = rs8[ai * 4 + m];
#pragma unroll
                for (int bj = 0; bj < 2; ++bj) { const size_t o = (size_t)row * FF + col0 + bj * HALF;
                    f32x4 v0 = acc[ai][bj][m][0] * rs, v1 = acc[ai][bj][m][1] * rs;
#pragma unroll
                    for (int j = 0; j < 4; ++j) { const float a = fmaxf(v0[j], 0.f), b = fmaxf(v1[j], 0.f); v0[j] = a * a; v1[j] = b * b; }
                    u32x4 w; w.x = pk2(v0[0], v0[1]); w.y = pk2(v0[2], v0[3]); w.z = pk2(v1[0], v1[1]); w.w = pk2(v1[2], v1[3]);
                    st16_wt(ws_rsrc(U), o * 2, w); } }
    }
};
struct EpiIn {
    bf16_t* ZS; bf16_t* RAWX; bf16_t* RAWBC; const float* ssq;
    __device__ __forceinline__ void operator()(const Acc& acc, const Unit& u, int wr, int wc, int fr, int fq) const {
        const int row0 = u.pm * BM + wr * 64 + fr; const int pn = u.pn;
        bf16_t* base; int ld, ct; bool act = false;
        if (pn < 8) { base = ZS; ld = DI; ct = pn; act = true; } else if (pn < 16) { base = RAWX; ld = DI; ct = pn - 8; } else { base = RAWBC; ld = 1024; ct = pn - 16; }
        const rsrc_t wsr = ws_rsrc(base);
        const int col0 = ct * BM + wc * 32 + 8 * fq;
        float rs8[8]; rstd8(ssq, row0, fq, rs8);
#pragma unroll
        for (int ai = 0; ai < 2; ++ai)
#pragma unroll
            for (int m = 0; m < 4; ++m) { const int row = row0 + ai * HALF + m * 16; const float rs = rs8[ai * 4 + m];
#pragma unroll
                for (int bj = 0; bj < 2; ++bj) { const size_t o = (size_t)row * ld + col0 + bj * HALF;
                    f32x4 v0 = acc[ai][bj][m][0] * rs, v1 = acc[ai][bj][m][1] * rs;
                    if (act) {
#pragma unroll
                        for (int j = 0; j < 4; ++j) { v0[j] = siluf(v0[j]); v1[j] = siluf(v1[j]); } }
                    u32x4 w; w.x = pk2(v0[0], v0[1]); w.y = pk2(v0[2], v0[3]); w.z = pk2(v1[0], v1[1]); w.w = pk2(v1[2], v1[3]);
                    if (act) st16_wt_nt(wsr, o * 2, w); else st16_wt(wsr, o * 2, w); } }
    }
};
}

struct Args {
    const float *x, *norm_mix_g, *norm_mlp_g, *pool_w, *pool_b, *pool_scale, *w_in, *conv_w, *conv_b, *dt_bias, *a_log, *d_skip, *norm_g, *w_out, *w1, *w2, *final_g;
    float* out; unsigned char* ws; int ph_lo, ph_hi;
};

__device__ __forceinline__ void transpose_item(const float* W, int K, int N, const float* gain, bf16_t* WT, int row_off, float* scr, int item, int lane) {
    const int nblk = N / 32, kb = item / nblk, nb = item % nblk, k0 = 64 * kb, n0 = 32 * nb;
    const int kr = lane >> 3, nq = (lane & 7) * 4;
    f32x4 v[8];
#pragma unroll
    for (int i = 0; i < 8; ++i) v[i] = __builtin_nontemporal_load((const f32x4*)(W + (size_t)(k0 + i * 8 + kr) * N + n0 + nq));
#pragma unroll
    for (int i = 0; i < 8; ++i) { const int kk = i * 8 + kr; f32x4 t = v[i]; if (gain) t = t * gain[k0 + kk];
        scr[kk * 33 + nq] = t[0]; scr[kk * 33 + nq + 1] = t[1]; scr[kk * 33 + nq + 2] = t[2]; scr[kk * 33 + nq + 3] = t[3]; }
    __builtin_amdgcn_wave_barrier(); asm volatile("s_waitcnt lgkmcnt(0)" ::: "memory");
    const int c = lane & 7;
#pragma unroll
    for (int j = 0; j < 4; ++j) { const int n = (lane >> 3) + 8 * j; const float* s = scr + (8 * c) * 33 + n;
        u32x4 o; o.x = pk2(s[0 * 33], s[1 * 33]); o.y = pk2(s[2 * 33], s[3 * 33]); o.z = pk2(s[4 * 33], s[5 * 33]); o.w = pk2(s[6 * 33], s[7 * 33]);
        *(u32x4*)(WT + (size_t)(row_off + n0 + n) * K + k0 + 8 * c) = o; }
    __builtin_amdgcn_wave_barrier(); asm volatile("s_waitcnt lgkmcnt(0)" ::: "memory");
}

__device__ __forceinline__ void phase_prologue(unsigned char* lds, const Args& a, const int wave) {
    const int lane = lane_id_opaque(), tid = wave * 64 + lane;
    unsigned char* ws = a.ws;
    {
        float* scr = (float*)(lds + wave * 16384);
        const int gw = blockIdx.x * 8 + wave, NGW = gridDim.x * 8;
        constexpr int I_POOL = 4 * (256 / 64) * (256 / 32), I_W1 = (D / 64) * (FF / 32), I_W2 = (FF / 64) * (D / 32), I_IN = (D / 64) * (INP / 32), I_OUT = (DI / 64) * (D / 32);
        constexpr int NITEMS = I_POOL + 2 * I_W1 + 2 * I_W2 + I_IN + I_OUT;
        for (int it = gw; it < NITEMS; it += NGW) {
            int r = it;
            if (r < I_POOL) { const int g = r / 32; transpose_item(a.pool_w + (size_t)g * 65536, 256, 256, nullptr, (bf16_t*)(ws + W_POOL), g * 256, scr, r % 32, lane); continue; } r -= I_POOL;
            if (r < I_W1) { transpose_item(a.w1, D, FF, a.norm_mlp_g, (bf16_t*)(ws + W_W1_0), 0, scr, r, lane); continue; } r -= I_W1;
            if (r < I_W1) { transpose_item(a.w1 + (size_t)D * FF, D, FF, a.norm_mlp_g + D, (bf16_t*)(ws + W_W1_1), 0, scr, r, lane); continue; } r -= I_W1;
            if (r < I_W2) { transpose_item(a.w2, FF, D, nullptr, (bf16_t*)(ws + W_W2_0), 0, scr, r, lane); continue; } r -= I_W2;
            if (r < I_W2) { transpose_item(a.w2 + (size_t)D * FF, FF, D, nullptr, (bf16_t*)(ws + W_W2_1), 0, scr, r, lane); continue; } r -= I_W2;
            if (r < I_IN) { transpose_item(a.w_in, D, INP, a.norm_mix_g + D, (bf16_t*)(ws + W_IN), 0, scr, r, lane); continue; } r -= I_IN;
            transpose_item(a.w_out, DI, D, a.norm_g, (bf16_t*)(ws + W_OUT), 0, scr, r, lane);
        }
    }
    lds_barrier();
    {
        float* vt = (float*)lds;
        bf16_t* mixed = (bf16_t*)(ws + WS_MIXED);
        for (int tt = blockIdx.x; tt < M / 16; tt += gridDim.x) {
            const int t0 = tt * 16, bpos0 = t0 & (SEQ - 1);
            {
                f32x4 xv[4][4]; bool ok[4];
#pragma unroll
                for (int i = 0; i < 4; ++i) { const int rr = wave + 8 * i; ok[i] = (rr < 31) && (bpos0 - 15 + rr >= 0);
#pragma unroll
                    for (int j = 0; j < 4; ++j) xv[i][j] = ok[i] ? *((const f32x4*)(a.x + (size_t)(t0 - 15 + rr) * D) + 64 * j + lane) : (f32x4){0.f, 0.f, 0.f, 0.f}; }
#pragma unroll
                for (int i = 0; i < 4; ++i) { const int rr = wave + 8 * i;
                    if (rr < 31) { float sq = 0.f;
#pragma unroll
                        for (int j = 0; j < 4; ++j) sq += (xv[i][j].x * xv[i][j].x + xv[i][j].y * xv[i][j].y) + (xv[i][j].z * xv[i][j].z + xv[i][j].w * xv[i][j].w);
                        const float rs = rsqrtf(wave_sum(sq) * (1.f / D) + EPS);
#pragma unroll
                        for (int j = 0; j < 4; ++j) *((f32x4*)(vt + rr * D) + 64 * j + lane) = xv[i][j] * rs; } }
            }
            lds_barrier();
            {
                const int cq = tid & 255, th = tid >> 8, tl = th * 8, gi = cq >> 6, w = 2 << gi;
                const f32x4 g4 = *(const f32x4*)(a.norm_mix_g + cq * 4);
                f32x4 sacc = {0.f, 0.f, 0.f, 0.f};
                const int jstart = tl - (w - 1);
                for (int j = jstart; j < tl + 8; ++j) {
                    const f32x4 v = *(const f32x4*)(vt + (j + 15) * D + cq * 4);
                    sacc += v;
                    const int jo = j - w;
                    if (jo >= jstart) sacc -= *(const f32x4*)(vt + (jo + 15) * D + cq * 4);
                    if (j >= tl) { const int pos = bpos0 + j; const int cnt = (pos + 1 < w) ? pos + 1 : w; const float ic = 1.f / (float)cnt;
                        const f32x4 mx = (sacc * ic - v) * g4;
                        u32x2 o; o.x = pk2(mx[0], mx[1]); o.y = pk2(mx[2], mx[3]);
                        *(u32x2*)(mixed + (size_t)(t0 + j) * D + cq * 4) = o; }
                }
            }
            lds_barrier();
        }
    }
}

__device__ __forceinline__ void phase_dt(unsigned char* lds, const Args& a, const int wave) {
    const int lane = lane_id_opaque(), tid = wave * 64 + lane, fr = lane & 15, q = lane >> 4;
    constexpr int WP = 1032;
    bf16_t* Wl = (bf16_t*)lds;
    {
        const bf16_t* Wg = (const bf16_t*)(a.ws + W_IN) + (size_t)NMAIN * D;
#pragma unroll
        for (int i = 0; i < 8; ++i) { const int idx = tid + i * 512, row = idx >> 7, ch = (idx & 127) * 8; *(u32x4*)(Wl + row * WP + ch) = *(const u32x4*)(Wg + (size_t)row * D + ch); }
    }
    lds_barrier();
    float* DT = (float*)(a.ws + WS_DT);
    for (int it = blockIdx.x * 8 + wave; it < 2 * (M / 16); it += gridDim.x * 8) {
        const int row0 = (it >> 1) * 16, nt = it & 1;
        const bf16_t* Ag = (const bf16_t*)(a.ws + WS_HB) + (size_t)(row0 + fr) * D + q * 8;
        const bf16_t* Bl = Wl + (nt * 16 + fr) * WP + q * 8;
        f32x4 acc = {0.f, 0.f, 0.f, 0.f};
#pragma unroll
        for (int k0 = 0; k0 < 32; k0 += 16) { bf16x8 av[16];
#pragma unroll
            for (int i = 0; i < 16; ++i) av[i] = *(const bf16x8*)(Ag + (k0 + i) * 32);
#pragma unroll
            for (int i = 0; i < 16; ++i) acc = mfma16(av[i], *(const bf16x8*)(Bl + (k0 + i) * 32), acc); }
        const float bb = a.dt_bias[nt * 16 + fr];
#pragma unroll
        for (int r = 0; r < 4; ++r) { const int row = row0 + q * 4 + r; const float rs = rstd_from_ssq((const float*)(a.ws + WS_SSQ), row);
            const float v = acc[r] * rs + bb; DT[dti(row, nt * 16 + fr)] = v > 20.f ? v : log1pf(__expf(v)); }
    }
}

constexpr int LP = 136;
__device__ __forceinline__ void phase_bc(unsigned char* lds, const Args& a, const int wave) {
    const int lane = lane_id_opaque(), tid = wave * 64 + lane, fr = lane & 15, q = lane >> 4;
    bf16_t* Bs = (bf16_t*)lds; bf16_t* Cs = Bs + 128 * LP; bf16_t* BsT = Cs + 128 * LP; float* acs8 = (float*)(BsT + 128 * LP); float* dt8 = acs8 + 1024; float* cwl = dt8 + 1024;
    const bf16_t* RAWBC = (const bf16_t*)(a.ws + WS_RAWBC); const bf16_t* RAWX = (const bf16_t*)(a.ws + WS_RAWX);
    const float* DT = (const float*)(a.ws + WS_DT); float* ACS = (float*)(a.ws + WS_ACS);
    for (int unit = blockIdx.x; unit < 512; unit += gridDim.x) {
        const int g = unit & 3, bc = unit >> 2, c = bc & 31, b = bc >> 5;
        const int t0 = b * SEQ + c * 128;
        const size_t tile = (size_t)unit * 16384;
        bf16_t* CB = (bf16_t*)(a.ws + WS_CB) + tile;
        bf16_t* ST = (bf16_t*)a.out + (size_t)unit * 8 * 8192;
        {
            const int cg8 = tid & 31, rg = tid >> 5; const bool isC = cg8 >= 16; const int n0 = (cg8 & 15) * 8;
            const int col = (isC ? 512 : 0) + g * 128 + n0;
            float cw[4][8], cbv[8];
#pragma unroll
            for (int k = 0; k < 4; ++k) { const f32x4 w0 = *(const f32x4*)(a.conv_w + (size_t)k * 3072 + 2048 + col), w1 = *(const f32x4*)(a.conv_w + (size_t)k * 3072 + 2048 + col + 4);
#pragma unroll
                for (int j = 0; j < 4; ++j) { cw[k][j] = w0[j]; cw[k][4 + j] = w1[j]; } }
            { const f32x4 b0 = *(const f32x4*)(a.conv_b + 2048 + col), b1 = *(const f32x4*)(a.conv_b + 2048 + col + 4);
#pragma unroll
              for (int j = 0; j < 4; ++j) { cbv[j] = b0[j]; cbv[4 + j] = b1[j]; } }
            float xr[11][8];
#pragma unroll
            for (int i = 0; i < 11; ++i) { const int row = rg * 8 - 3 + i; const bool zr_ = (c == 0 && row < 0);
                u32x4 v = __builtin_nontemporal_load((const u32x4*)(RAWBC + (size_t)(t0 + (zr_ ? 0 : row)) * 1024 + col)); if (zr_) v = (u32x4){0u, 0u, 0u, 0u};
                xr[i][0] = bflo(v.x); xr[i][1] = bfhi(v.x); xr[i][2] = bflo(v.y); xr[i][3] = bfhi(v.y); xr[i][4] = bflo(v.z); xr[i][5] = bfhi(v.z); xr[i][6] = bflo(v.w); xr[i][7] = bfhi(v.w); }
            bf16_t* dst = isC ? Cs : Bs;
#pragma unroll
            for (int i = 0; i < 8; ++i) { float o[8];
#pragma unroll
                for (int j = 0; j < 8; ++j) o[j] = siluf(cbv[j] + cw[0][j] * xr[i][j] + cw[1][j] * xr[i + 1][j] + cw[2][j] * xr[i + 2][j] + cw[3][j] * xr[i + 3][j]);
                u32x4 w; w.x = pk2(o[0], o[1]); w.y = pk2(o[2], o[3]); w.z = pk2(o[4], o[5]); w.w = pk2(o[6], o[7]);
                *(u32x4*)(dst + (rg * 8 + i) * LP + n0) = w; }
        }
        {
            const int h = g * 8 + wave; const float av = -__expf(a.a_log[h]);
            const f32x2_t dd_ = *(const f32x2_t*)(DT + dti(t0, h) + 2 * lane); const float d0 = dd_.x, d1 = dd_.y;
            const float v0 = d0 * av, v1 = d1 * av;
            float s = v0 + v1;
#pragma unroll
            for (int o = 1; o < 64; o <<= 1) { const float t = __shfl_up(s, o); if (lane >= o) s += t; }
            *(f32x2_t*)(ACS + dti(t0, h) + 2 * lane) = (f32x2_t){s - v1, s};
#pragma unroll
            for (int k = 0; k < 4; ++k) cwl[k * 512 + tid] = a.conv_w[(size_t)k * 3072 + g * 512 + tid];
            cwl[4 * 512 + tid] = a.conv_b[g * 512 + tid];
            acs8[wave * 128 + 2 * lane] = s - v1; acs8[wave * 128 + 2 * lane + 1] = s; dt8[wave * 128 + 2 * lane] = d0; dt8[wave * 128 + 2 * lane + 1] = d1;
        }
        lds_barrier();
        {
            const int n = tid & 127, lg = tid >> 7;
#pragma unroll
            for (int i = 0; i < 4; ++i) { const int l0 = lg * 32 + i * 8; const bf16_t* sp_ = Bs + l0 * LP + n;
                u32x4 w; w.x = (unsigned)sp_[0] | ((unsigned)sp_[LP] << 16); w.y = (unsigned)sp_[2 * LP] | ((unsigned)sp_[3 * LP] << 16); w.z = (unsigned)sp_[4 * LP] | ((unsigned)sp_[5 * LP] << 16); w.w = (unsigned)sp_[6 * LP] | ((unsigned)sp_[7 * LP] << 16);
                *(u32x4*)(BsT + n * LP + l0) = w; }
        }
        {
            bf16x8 cf[4];
#pragma unroll
            for (int kk = 0; kk < 4; ++kk) cf[kk] = *(const bf16x8*)(Cs + (16 * wave + fr) * LP + kk * 32 + q * 8);
            __builtin_amdgcn_s_setprio(1);
#pragma unroll
            for (int st = 0; st < 8; st += 2) { u32x2 o2[2];
#pragma unroll
                for (int e = 0; e < 2; ++e) { f32x4 acc = {0.f, 0.f, 0.f, 0.f};
#pragma unroll
                    for (int kk = 0; kk < 4; ++kk) { const bf16x8 bfm = *(const bf16x8*)(Bs + (16 * (st + e) + fr) * LP + kk * 32 + q * 8); acc = mfma16(bfm, cf[kk], acc); }
                    o2[e].x = pk2(acc[0], acc[1]); o2[e].y = pk2(acc[2], acc[3]); }
                *(u32x4*)(CB + (16 * wave + fr) * 128 + 16 * WSEL(st, q) + WOFF(q)) = widen16(o2[0], o2[1]); }
            __builtin_amdgcn_s_setprio(0);
        }
        lds_barrier();
        {
            bf16x8 bt[4];
#pragma unroll
            for (int kk = 0; kk < 4; ++kk) bt[kk] = *(const bf16x8*)(BsT + (16 * wave + fr) * LP + kk * 32 + q * 8);
            const int s0 = (wave * 8 + (lane >> 3)) * 2, p0 = (lane & 7) * 8;
            u32x4 xq[5];
#pragma unroll
            for (int i = 0; i < 5; ++i) { const int row = s0 - 3 + i; const bool zr_ = (c == 0 && row < 0); const u32x4 v_ = __builtin_nontemporal_load((const u32x4*)(RAWX + (size_t)(t0 + (zr_ ? 0 : row)) * DI + (g * 8) * 64 + p0)); xq[i] = zr_ ? (u32x4){0u, 0u, 0u, 0u} : v_; }
            for (int hh = 0; hh < 8; ++hh) {
                const int ch0 = (g * 8 + hh) * 64 + p0;
                bf16_t* xe = (hh & 1) ? Cs : Bs;
                {
                    float cw[4][8], cbv[8];
#pragma unroll
                    for (int k = 0; k < 5; ++k) { const f32x4 w0 = *(const f32x4*)(cwl + k * 512 + hh * 64 + p0), w1 = *(const f32x4*)(cwl + k * 512 + hh * 64 + p0 + 4);
#pragma unroll
                        for (int j = 0; j < 4; ++j) { if (k < 4) { cw[k][j] = w0[j]; cw[k][4 + j] = w1[j]; } else { cbv[j] = w0[j]; cbv[4 + j] = w1[j]; } } }
                    float xr[5][8];
#pragma unroll
                    for (int i = 0; i < 5; ++i) { const u32x4 v = xq[i];
                        xr[i][0] = bflo(v.x); xr[i][1] = bfhi(v.x); xr[i][2] = bflo(v.y); xr[i][3] = bfhi(v.y); xr[i][4] = bflo(v.z); xr[i][5] = bfhi(v.z); xr[i][6] = bflo(v.w); xr[i][7] = bfhi(v.w); }
                    const float acL = acs8[hh * 128 + 127];
                    const float e0 = dt8[hh * 128 + s0] * __expf(acL - acs8[hh * 128 + s0]), e1 = dt8[hh * 128 + s0 + 1] * __expf(acL - acs8[hh * 128 + s0 + 1]);
#pragma unroll
                    for (int j = 0; j < 8; ++j) {
                        const float x0 = siluf(cbv[j] + cw[0][j] * xr[0][j] + cw[1][j] * xr[1][j] + cw[2][j] * xr[2][j] + cw[3][j] * xr[3][j]);
                        const float x1 = siluf(cbv[j] + cw[0][j] * xr[1][j] + cw[1][j] * xr[2][j] + cw[2][j] * xr[3][j] + cw[3][j] * xr[4][j]);
                        *(unsigned*)(xe + (p0 + j) * LP + s0) = pk2(x0 * e0, x1 * e1); }
                }
                if (hh + 1 < 8) {
#pragma unroll
                    for (int i = 0; i < 5; ++i) { const int row = s0 - 3 + i; const bool zr_ = (c == 0 && row < 0); const u32x4 v_ = __builtin_nontemporal_load((const u32x4*)(RAWX + (size_t)(t0 + (zr_ ? 0 : row)) * DI + ch0 + 64)); xq[i] = zr_ ? (u32x4){0u, 0u, 0u, 0u} : v_; } }
                lds_barrier();
                bf16_t* STh = ST + (size_t)hh * 8192;
                __builtin_amdgcn_s_setprio(1);
#pragma unroll
                for (int mt = 0; mt < 4; mt += 2) { u32x2 o2[2];
#pragma unroll
                    for (int e = 0; e < 2; ++e) { f32x4 acc = {0.f, 0.f, 0.f, 0.f};
#pragma unroll
                        for (int kk = 0; kk < 4; ++kk) { const bf16x8 xo = *(const bf16x8*)(xe + ((mt + e) * 16 + fr) * LP + kk * 32 + q * 8); acc = mfma16(bt[kk], xo, acc); }
                        o2[e].x = pk2(acc[0], acc[1]); o2[e].y = pk2(acc[2], acc[3]); }
                    *(u32x4*)(STh + (WSEL(mt, q) * 16 + fr) * 128 + 16 * wave + WOFF(q)) = widen16(o2[0], o2[1]); }
                __builtin_amdgcn_s_setprio(0);
            }
        }
        lds_barrier();
    }
}

__device__ __forceinline__ void phase_scan(const Args& a, const int wave) {
    const int lane = lane_id_opaque(), tid = wave * 64 + lane;
    const float* ACS = (const float*)(a.ws + WS_ACS);
    for (int gid = blockIdx.x * 512 + tid; gid < 128 * 1024; gid += gridDim.x * 512) {
        const int bh = gid >> 10, b = bh >> 5, h = bh & 31, e = (gid & 1023) * 8;
        float prev[8];
#pragma unroll
        for (int j = 0; j < 8; ++j) prev[j] = 0.f;
        for (int c0 = 0; c0 < 32; c0 += 8) {
            u32x4 sv[8]; float cd[8];
#pragma unroll
            for (int i = 0; i < 8; ++i) { const int c = c0 + i; sv[i] = __builtin_nontemporal_load((const u32x4*)((const bf16_t*)a.out + (size_t)((b * 32 + c) * 32 + h) * 8192 + e)); cd[i] = ACS[dti(b * SEQ + c * 128 + 127, h)]; }
#pragma unroll
            for (int i = 0; i < 8; ++i) { const int c = c0 + i; const float d = __expf(cd[i]);
                u32x4 o; o.x = pk2(prev[0], prev[1]); o.y = pk2(prev[2], prev[3]); o.z = pk2(prev[4], prev[5]); o.w = pk2(prev[6], prev[7]);
                *(u32x4*)((bf16_t*)a.out + (size_t)((b * 32 + c) * 32 + h) * 8192 + e) = o;
                const u32x4 v = sv[i];
                prev[0] = prev[0] * d + bflo(v.x); prev[1] = prev[1] * d + bfhi(v.x); prev[2] = prev[2] * d + bflo(v.y); prev[3] = prev[3] * d + bfhi(v.y);
                prev[4] = prev[4] * d + bflo(v.z); prev[5] = prev[5] * d + bfhi(v.z); prev[6] = prev[6] * d + bflo(v.w); prev[7] = prev[7] * d + bfhi(v.w); }
        }
    }
}

__device__ __forceinline__ void phase_y(unsigned char* lds, const Args& a, const int w, const bool do_store = true) {
    const int lane = lane_id_opaque(), tid = w * 64 + lane, fr = lane & 15, q = lane >> 4;
    bf16_t* Cs = (bf16_t*)lds; bf16_t* xd0 = Cs + 128 * LP; bf16_t* xd1 = xd0 + 64 * LP; bf16_t* pvs0 = xd1 + 64 * LP; bf16_t* pvs1 = pvs0 + 64 * LP; float* acs8 = (float*)(pvs1 + 64 * LP); float* dt8 = acs8 + 1024; float* cwl = dt8 + 1024; float* ddl = cwl + 2560;
    const bf16_t* RAWBC = (const bf16_t*)(a.ws + WS_RAWBC); const bf16_t* RAWX = (const bf16_t*)(a.ws + WS_RAWX); bf16_t* ZS = (bf16_t*)(a.ws + WS_ZS);
    const float* DT = (const float*)(a.ws + WS_DT); const float* ACS = (const float*)(a.ws + WS_ACS);
    for (int unit = blockIdx.x; unit < 512; unit += gridDim.x) {
        const int g = unit & 3, bc = unit >> 2, c = bc & 31, b = bc >> 5;
        const int t0 = b * SEQ + c * 128;
        const bf16_t* CB = (const bf16_t*)(a.ws + WS_CB) + (size_t)unit * 16384;
        const bf16_t* PV = (const bf16_t*)a.out + (size_t)unit * 8 * 8192;
        {
            const int n0 = (tid & 15) * 8, rg = tid >> 4; const int col = 512 + g * 128 + n0;
            float cw[4][8], cbv[8];
#pragma unroll
            for (int k = 0; k < 4; ++k) { const f32x4 w0 = *(const f32x4*)(a.conv_w + (size_t)k * 3072 + 2048 + col), w1 = *(const f32x4*)(a.conv_w + (size_t)k * 3072 + 2048 + col + 4);
#pragma unroll
                for (int j = 0; j < 4; ++j) { cw[k][j] = w0[j]; cw[k][4 + j] = w1[j]; } }
            { const f32x4 b0 = *(const f32x4*)(a.conv_b + 2048 + col), b1 = *(const f32x4*)(a.conv_b + 2048 + col + 4);
#pragma unroll
              for (int j = 0; j < 4; ++j) { cbv[j] = b0[j]; cbv[4 + j] = b1[j]; } }
            float xr[7][8];
#pragma unroll
            for (int i = 0; i < 7; ++i) { const int row = rg * 4 - 3 + i; const bool zr_ = (c == 0 && row < 0);
                u32x4 v = __builtin_nontemporal_load((const u32x4*)(RAWBC + (size_t)(t0 + (zr_ ? 0 : row)) * 1024 + col)); if (zr_) v = (u32x4){0u, 0u, 0u, 0u};
                xr[i][0] = bflo(v.x); xr[i][1] = bfhi(v.x); xr[i][2] = bflo(v.y); xr[i][3] = bfhi(v.y); xr[i][4] = bflo(v.z); xr[i][5] = bfhi(v.z); xr[i][6] = bflo(v.w); xr[i][7] = bfhi(v.w); }
#pragma unroll
            for (int i = 0; i < 4; ++i) { float o[8];
#pragma unroll
                for (int j = 0; j < 8; ++j) o[j] = siluf(cbv[j] + cw[0][j] * xr[i][j] + cw[1][j] * xr[i + 1][j] + cw[2][j] * xr[i + 2][j] + cw[3][j] * xr[i + 3][j]);
                u32x4 wv; wv.x = pk2(o[0], o[1]); wv.y = pk2(o[2], o[3]); wv.z = pk2(o[4], o[5]); wv.w = pk2(o[6], o[7]);
                *(u32x4*)(Cs + (rg * 4 + i) * LP + n0) = wv; }
        }
#pragma unroll
        for (int k = 0; k < 4; ++k) cwl[k * 512 + tid] = a.conv_w[(size_t)k * 3072 + g * 512 + tid];
        cwl[4 * 512 + tid] = a.conv_b[g * 512 + tid];
        { const int h = g * 8 + w;
          *(f32x2_t*)(acs8 + w * 128 + 2 * lane) = *(const f32x2_t*)(ACS + dti(t0, h) + 2 * lane) * 1.4426950408889634f;
          const f32x2_t dv_ = *(const f32x2_t*)(DT + dti(t0, h) + 2 * lane); *(f32x2_t*)(dt8 + w * 128 + 2 * lane) = dv_;
          const float dk_ = a.d_skip[h]; *(f32x2_t*)(ddl + w * 128 + 2 * lane) = (f32x2_t){dk_ / dv_.x, dk_ / dv_.y}; }
        lds_barrier();
        const int l = 16 * w + fr;
        bf16x8 aC[4]; u32x4 cbr[4];
#pragma unroll
        for (int kk = 0; kk < 4; ++kk) { aC[kk] = *(const bf16x8*)(Cs + l * LP + kk * 32 + q * 8); cbr[kk] = __builtin_nontemporal_load((const u32x4*)(CB + l * 128 + kk * 32 + q * 8)); }
        const int s0 = (w * 8 + (lane >> 3)) * 2, p0 = (lane & 7) * 8;
        u32x4 xq[5];
#pragma unroll
        for (int i = 0; i < 5; ++i) { const int row = s0 - 3 + i; const bool zr_ = (c == 0 && row < 0); const u32x4 v_ = __builtin_nontemporal_load((const u32x4*)(RAWX + (size_t)(t0 + (zr_ ? 0 : row)) * DI + (g * 8) * 64 + p0)); xq[i] = zr_ ? (u32x4){0u, 0u, 0u, 0u} : v_; }
        u32x4 pq[2], zw[2];
        const int pvr = tid >> 3, pvc = (tid & 7) * 16;
#define Y_LOAD_P(hx) do { const bf16_t* src_ = PV + (size_t)(hx) * 8192 + pvr * 128 + pvc; pq[0] = __builtin_nontemporal_load((const u32x4*)src_); pq[1] = __builtin_nontemporal_load((const u32x4*)(src_ + 8)); } while (0)
#define Y_LOAD_Z(hx) do { _Pragma("unroll") for (int pr = 0; pr < 2; ++pr) zw[pr] = *(const u32x4*)(ZS + (size_t)(t0 + l) * DI + (g * 8 + (hx)) * 64 + WSEL(2 * pr, q) * 16 + WOFF(q)); } while (0)
        Y_LOAD_P(0); Y_LOAD_Z(0);
        float gss = 0.f;
        for (int hh = 0; hh < 8; ++hh) {
            const int h = g * 8 + hh, ch0 = h * 64 + p0;
            bf16_t* xd = (hh & 1) ? xd1 : xd0; bf16_t* pvs = (hh & 1) ? pvs1 : pvs0;
            *(u32x4*)(pvs + pvr * LP + pvc) = pq[0]; *(u32x4*)(pvs + pvr * LP + pvc + 8) = pq[1];
            {
                float cw[4][8], cbv[8];
#pragma unroll
                for (int k = 0; k < 5; ++k) { const f32x4 w0 = *(const f32x4*)(cwl + k * 512 + hh * 64 + p0), w1 = *(const f32x4*)(cwl + k * 512 + hh * 64 + p0 + 4);
#pragma unroll
                    for (int j = 0; j < 4; ++j) { if (k < 4) { cw[k][j] = w0[j]; cw[k][4 + j] = w1[j]; } else { cbv[j] = w0[j]; cbv[4 + j] = w1[j]; } } }
                float xr[5][8];
#pragma unroll
                for (int i = 0; i < 5; ++i) { const u32x4 v = xq[i];
                    xr[i][0] = bflo(v.x); xr[i][1] = bfhi(v.x); xr[i][2] = bflo(v.y); xr[i][3] = bfhi(v.y); xr[i][4] = bflo(v.z); xr[i][5] = bfhi(v.z); xr[i][6] = bflo(v.w); xr[i][7] = bfhi(v.w); }
                const float dt0 = dt8[hh * 128 + s0], dt1 = dt8[hh * 128 + s0 + 1];
#pragma unroll
                for (int j = 0; j < 8; ++j) {
                    const float x0 = siluf(cbv[j] + cw[0][j] * xr[0][j] + cw[1][j] * xr[1][j] + cw[2][j] * xr[2][j] + cw[3][j] * xr[3][j]);
                    const float x1 = siluf(cbv[j] + cw[0][j] * xr[1][j] + cw[1][j] * xr[2][j] + cw[2][j] * xr[3][j] + cw[3][j] * xr[4][j]);
                    *(unsigned*)(xd + (p0 + j) * LP + s0) = pk2(x0 * dt0, x1 * dt1); }
            }
            if (hh + 1 < 8) {
#pragma unroll
                for (int i = 0; i < 5; ++i) { const int row = s0 - 3 + i; const bool zr_ = (c == 0 && row < 0); const u32x4 v_ = __builtin_nontemporal_load((const u32x4*)(RAWX + (size_t)(t0 + (zr_ ? 0 : row)) * DI + ch0 + 64)); xq[i] = zr_ ? (u32x4){0u, 0u, 0u, 0u} : v_; } }
            lds_barrier();
            if (hh + 1 < 8) Y_LOAD_P(hh + 1);
            __builtin_amdgcn_s_setprio(1);
            bf16x8 aS[4];
            const float al = acs8[hh * 128 + l], dd = ddl[hh * 128 + l];
#pragma unroll
            for (int kk = 0; kk < 4; ++kk) { aS[kk] = (bf16x8){0, 0, 0, 0, 0, 0, 0, 0};
                if (kk * 32 <= 16 * w + 15) {
                    const u32x4 raw = cbr[kk];
                    float cv[8] = {bflo(raw.x), bfhi(raw.x), bflo(raw.y), bfhi(raw.y), bflo(raw.z), bfhi(raw.z), bflo(raw.w), bfhi(raw.w)};
                    const int sb = kk * 32 + q * 8;
#pragma unroll
                    for (int j = 0; j < 8; ++j) { const int s = sb + j; float v = (s <= l) ? cv[j] * __builtin_amdgcn_exp2f(al - acs8[hh * 128 + s]) : 0.f; if (s == l) v += dd; cv[j] = v; }
                    u32x4 pk; pk.x = pk2(cv[0], cv[1]); pk.y = pk2(cv[2], cv[3]); pk.z = pk2(cv[4], cv[5]); pk.w = pk2(cv[6], cv[7]);
                    aS[kk] = __builtin_bit_cast(bf16x8, pk); } }
            const float eo = __builtin_amdgcn_exp2f(al); float ss = 0.f;
            u32x2 zq[4], oo[4]; unwiden16(zw[0], zq[0], zq[1]); unwiden16(zw[1], zq[2], zq[3]);
#pragma unroll
            for (int mt = 0; mt < 4; ++mt) { f32x4 accO = {0.f, 0.f, 0.f, 0.f}, accD = {0.f, 0.f, 0.f, 0.f};
#pragma unroll
                for (int kk = 0; kk < 4; ++kk) { const bf16x8 po = *(const bf16x8*)(pvs + (mt * 16 + fr) * LP + kk * 32 + q * 8); accO = mfma16(po, aC[kk], accO); }
#pragma unroll
                for (int kk = 0; kk < 4; ++kk) if (kk * 32 <= 16 * w + 15) { const bf16x8 xo = *(const bf16x8*)(xd + (mt * 16 + fr) * LP + kk * 32 + q * 8); accD = mfma16(xo, aS[kk], accD); }
                const u32x2 z = zq[mt];
                const float y0 = (accD[0] + eo * accO[0]) * bflo(z.x), y1 = (accD[1] + eo * accO[1]) * bfhi(z.x), y2 = (accD[2] + eo * accO[2]) * bflo(z.y), y3 = (accD[3] + eo * accO[3]) * bfhi(z.y);
                oo[mt].x = pk2(y0, y1); oo[mt].y = pk2(y2, y3);
                ss += (y0 * y0 + y1 * y1) + (y2 * y2 + y3 * y3); }
#pragma unroll
            for (int pr = 0; pr < 2; ++pr) { const u32x4 wv = widen16(oo[2 * pr], oo[2 * pr + 1]);
                if (do_store) *(u32x4*)(ZS + (size_t)(t0 + l) * DI + h * 64 + WSEL(2 * pr, q) * 16 + WOFF(q)) = wv; }
            __builtin_amdgcn_s_setprio(0);
            gss += ss;
            if (hh + 1 < 8) Y_LOAD_Z(hh + 1);
        }
#undef Y_LOAD_P
#undef Y_LOAD_Z
        gss += __shfl_xor(gss, 16); gss += __shfl_xor(gss, 32);
        {
            const float rs = rsqrtf(gss * (1.f / 512.f) + EPS);
#pragma unroll 2
            for (int hh = 0; hh < 8; ++hh)
#pragma unroll
                for (int pr = 0; pr < 2; ++pr) { const int col = (g * 8 + hh) * 64 + WSEL(2 * pr, q) * 16 + WOFF(q);
                    u32x4* p = (u32x4*)(ZS + (size_t)(t0 + l) * DI + col); const u32x4 v = *p;
                    u32x4 o; o.x = pk2(bflo(v.x) * rs, bfhi(v.x) * rs); o.y = pk2(bflo(v.y) * rs, bfhi(v.y) * rs); o.z = pk2(bflo(v.z) * rs, bfhi(v.z) * rs); o.w = pk2(bflo(v.w) * rs, bfhi(v.w) * rs);
                    if (do_store) *p = o; }
        }
        lds_barrier();
    }
}

__device__ __forceinline__ void phase_final(const Args& a, const int wave) {
    const int lane = lane_id_opaque();
    const bf16_t* hb = (const bf16_t*)(a.ws + WS_HB);
    for (int row = blockIdx.x * 8 + wave; row < M; row += gridDim.x * 8) {
        const float rs = rstd_from_ssq((const float*)(a.ws + WS_SSQ), row);
        f32x4* p = (f32x4*)(a.out + (size_t)row * D);
#pragma unroll
        for (int j = 0; j < 2; ++j) { const int c = j * 512 + lane * 8; const u32x4 hv = __builtin_nontemporal_load((const u32x4*)(hb + (size_t)row * D + c));
            const f32x4 g0 = *(const f32x4*)(a.final_g + c), g1 = *(const f32x4*)(a.final_g + c + 4);
            __builtin_nontemporal_store((f32x4){bflo(hv.x), bfhi(hv.x), bflo(hv.y), bfhi(hv.y)} * rs * g0, &p[c / 4]); __builtin_nontemporal_store((f32x4){bflo(hv.z), bfhi(hv.z), bflo(hv.w), bfhi(hv.w)} * rs * g1, &p[c / 4 + 1]); }
    }
}

constexpr int NPHASE = 12;
typedef const __attribute__((address_space(4))) Args* KArgsPtr;
#define LOADARGS const Args a = *(const Args*)kp; unsigned char* ws = a.ws; float* ssq = (float*)(ws + WS_SSQ); bf16_t* hb = (bf16_t*)(ws + WS_HB); bf16_t* U = (bf16_t*)(ws + WS_U); (void)ssq; (void)hb; (void)U
__global__ void __launch_bounds__(512, 2) fwd_megakernel(Args a_unused) {
    extern __shared__ __attribute__((aligned(16))) unsigned char lds[];
    cg::grid_group grid = cg::this_grid();
    KArgsPtr kp = (KArgsPtr)__builtin_amdgcn_kernarg_segment_ptr();
    LAS unsigned char* l3 = (LAS unsigned char*)lds;
    const int G = gridDim.x, bx = blockIdx.x;
#define IN(k) (kp->ph_lo <= (k) && (k) < kp->ph_hi)
    const int wid_s = __builtin_amdgcn_readfirstlane(threadIdx.x >> 6);
    volatile LAS unsigned* barst = (volatile LAS unsigned*)(l3 + LDS_BARST);
    if (threadIdx.x < 2) barst[threadIdx.x] = 0u;
    __syncthreads();
    (void)xcd_barrier_post((unsigned*)(kp->ws + WS_BAR), barst);
    if (kp->ph_lo < 0) grid.sync();
#define SEAM(k) do { if (IN(k) && IN((k) + 1)) { { XcdBarrier xb_; xb_.bar = (unsigned*)(kp->ws + WS_BAR); xb_.x = xb_xcc_id(); xb_.st = (volatile LAS unsigned*)(l3 + LDS_BARST); xcd_barrier(xb_, wid_s == 0 && lane_id_opaque() == 0); } } } while (0)

    if (IN(0)) { LOADARGS; phase_prologue(lds, a, wid_s); } SEAM(0);
    if (IN(1)) { LOADARGS; pg8::Gemm g{(const bf16_t*)(ws + WS_MIXED), (const bf16_t*)(ws + W_POOL), M, D, 256, D, 256}; pg8::StaticOrder S; S.init(M, D, G, bx);
        pg8::EpiPool E{a.x, hb, a.pool_b, a.pool_scale, ssq}; pg8::gemm_phase<pg8::EpiPool, true>(l3, g, S, E, wid_s); } SEAM(1);
    if (IN(2)) { LOADARGS; pg8::Gemm g{hb, (const bf16_t*)(ws + W_W1_0), M, FF, D, D, 0}; pg8::StaticOrder S; S.init(M, FF, G, bx);
        pg8::EpiUp E{U, ssq}; pg8::gemm_phase<pg8::EpiUp, true>(l3, g, S, E, wid_s); } SEAM(2);
    if (IN(3)) { LOADARGS; pg8::Gemm g{U, (const bf16_t*)(ws + W_W2_0), M, D, FF, FF, 0}; pg8::StaticOrder S; S.init(M, D, G, bx);
        pg8::EpiRes E{hb, ssq}; pg8::gemm_phase<pg8::EpiRes, true>(l3, g, S, E, wid_s); } SEAM(3);
    if (IN(4)) { LOADARGS; pg8::Gemm g{hb, (const bf16_t*)(ws + W_IN), M, NMAIN, D, D, 0}; pg8::StaticOrder S; S.init(M, NMAIN, G, bx);
        pg8::EpiIn E{(bf16_t*)(ws + WS_ZS), (bf16_t*)(ws + WS_RAWX), (bf16_t*)(ws + WS_RAWBC), ssq}; pg8::gemm_phase<pg8::EpiIn, true>(l3, g, S, E, wid_s);
        phase_dt(lds, a, wid_s); } SEAM(4);
    if (IN(5)) { LOADARGS;
        phase_bc(lds, a, wid_s); } SEAM(5);
    if (IN(6)) { LOADARGS; phase_scan(a, wid_s); } SEAM(6);
    if (IN(7)) { LOADARGS;
        phase_y(lds, a, wid_s); } SEAM(7);
    if (IN(8)) { LOADARGS; pg8::Gemm g{(const bf16_t*)(ws + WS_ZS), (const bf16_t*)(ws + W_OUT), M, D, DI, DI, 0}; pg8::StaticOrder S; S.init(M, D, G, bx);
        pg8::EpiRes E{hb, ssq}; pg8::gemm_phase<pg8::EpiRes, true>(l3, g, S, E, wid_s); } SEAM(8);
    if (IN(9)) { LOADARGS; pg8::Gemm g{hb, (const bf16_t*)(ws + W_W1_1), M, FF, D, D, 0}; pg8::StaticOrder S; S.init(M, FF, G, bx);
        pg8::EpiUp E{U, ssq}; pg8::gemm_phase<pg8::EpiUp, true>(l3, g, S, E, wid_s); } SEAM(9);
    if (IN(10)) { LOADARGS; pg8::Gemm g{U, (const bf16_t*)(ws + W_W2_1), M, D, FF, FF, 0}; pg8::StaticOrder S; S.init(M, D, G, bx);
        pg8::EpiRes E{hb, ssq}; pg8::gemm_phase<pg8::EpiRes, true>(l3, g, S, E, wid_s); } SEAM(10);
    if (IN(11)) { LOADARGS; phase_final(a, wid_s); }
#undef IN
#undef SEAM
}

extern "C" void kernel_launch(void* const* d_in, const int* in_sizes, int n_in, void* d_out, int out_size, void* d_ws, size_t ws_size, hipStream_t stream) {
    static int grid = 0;
    if (grid == 0) {
        if (n_in != 17 || in_sizes[0] != M * D || out_size != M * D || ws_size < WS_END) { fprintf(stderr, "kernel_launch: unexpected shapes (n_in %d, in0 %d, out %d, ws %zu)\n", n_in, n_in > 0 ? in_sizes[0] : -1, out_size, ws_size); grid = -1; return; }
        int dev = 0, cus = 0, per_cu = 0;
        hipGetDevice(&dev); hipDeviceGetAttribute(&cus, hipDeviceAttributeMultiprocessorCount, dev);
        if (hipFuncSetAttribute((const void*)fwd_megakernel, hipFuncAttributeMaxDynamicSharedMemorySize, LDS_BYTES) != hipSuccess) { fprintf(stderr, "kernel_launch: hipFuncSetAttribute failed\n"); grid = -1; return; }
        if (hipOccupancyMaxActiveBlocksPerMultiprocessor(&per_cu, (const void*)fwd_megakernel, 512, LDS_BYTES) != hipSuccess || per_cu < 1) { fprintf(stderr, "kernel_launch: occupancy query says %d\n", per_cu); per_cu = 1; (void)hipGetLastError(); }
        grid = cus * (per_cu > 1 ? 1 : per_cu);
        if (grid > 256) grid = 256;
    }
    if (grid < 0) return;
    if (hipMemsetAsync((unsigned char*)d_ws + WS_BAR, 0, 16384, stream) != hipSuccess) { fprintf(stderr, "kernel_launch: memset of the barrier words failed\n"); return; }
    Args a{};
    a.x = (const float*)d_in[0]; a.norm_mix_g = (const float*)d_in[1]; a.norm_mlp_g = (const float*)d_in[2]; a.pool_w = (const float*)d_in[3]; a.pool_b = (const float*)d_in[4];
    a.pool_scale = (const float*)d_in[5]; a.w_in = (const float*)d_in[6]; a.conv_w = (const float*)d_in[7]; a.conv_b = (const float*)d_in[8]; a.dt_bias = (const float*)d_in[9];
    a.a_log = (const float*)d_in[10]; a.d_skip = (const float*)d_in[11]; a.norm_g = (const float*)d_in[12]; a.w_out = (const float*)d_in[13]; a.w1 = (const float*)d_in[14];
    a.w2 = (const float*)d_in[15]; a.final_g = (const float*)d_in[16]; a.out = (float*)d_out; a.ws = (unsigned char*)d_ws;
#if MK_PER_PHASE
    for (int p = 0; p < NPHASE; ++p) { if (!((MK_PHASE_MASK >> p) & 1)) continue; a.ph_lo = p; a.ph_hi = p + 1; void* args[] = {&a};
        hipError_t e = hipLaunchCooperativeKernel((const void*)fwd_megakernel, dim3(grid), dim3(512), args, LDS_BYTES, stream);
        if (e != hipSuccess) { fprintf(stderr, "launch %d failed: %s\n", p, hipGetErrorString(e)); break; } }
#else
    a.ph_lo = 0; a.ph_hi = NPHASE; void* args[] = {&a};
    hipError_t e = hipLaunchCooperativeKernel((const void*)fwd_megakernel, dim3(grid), dim3(512), args, LDS_BYTES, stream);
    if (e != hipSuccess) fprintf(stderr, "cooperative launch failed: %s (grid %d)\n", hipGetErrorString(e), grid);
#endif
}
```

```cpp
#include <hip/hip_runtime.h>
#include <hip/hip_cooperative_groups.h>
#include <cstdio>
#include <cstdint>
namespace cg = cooperative_groups;

#ifndef MK_PHASE_MASK
#define MK_PHASE_MASK 0xFFF
#endif
#ifndef MK_PER_PHASE
#define MK_PER_PHASE 0
#endif

#define LAS __attribute__((address_space(3)))
typedef unsigned short bf16_t;
typedef short bf16x8 __attribute__((ext_vector_type(8)));
typedef float f32x4 __attribute__((ext_vector_type(4)));
typedef unsigned u32x4 __attribute__((ext_vector_type(4)));
typedef unsigned u32x2 __attribute__((ext_vector_type(2)));

constexpr int M = 16384, D = 1024, FF = 4096, DI = 2048, NH = 32, SEQ = 4096, INP = 5152, NMAIN = 5120;
constexpr float EPS = 1e-5f;
constexpr size_t MiB = 1u << 20;
constexpr size_t WS_SSQ = 0;
constexpr size_t WS_DT = 1 * MiB;
constexpr size_t WS_ACS = 3 * MiB;
constexpr size_t WS_BAR = 7 * MiB;
constexpr size_t WS_W = 8 * MiB;
constexpr size_t W_POOL = WS_W, W_W1_0 = WS_W + 1 * MiB, W_W2_0 = WS_W + 9 * MiB, W_IN = WS_W + 17 * MiB, W_OUT = WS_W + 28 * MiB, W_W1_1 = WS_W + 32 * MiB, W_W2_1 = WS_W + 40 * MiB;
constexpr size_t WS_CB = W_W1_0;
constexpr size_t WS_HB = 56 * MiB;
constexpr size_t WS_U = 88 * MiB;
constexpr size_t WS_MIXED = WS_U;
constexpr size_t WS_RAWX = 88 * MiB;
constexpr size_t WS_RAWBC = 152 * MiB;
constexpr size_t WS_ZS = 184 * MiB;
constexpr size_t WS_END = 248 * MiB;

__host__ __device__ constexpr size_t dti(int row, int h) { return ((size_t)(row >> 7) * 32 + h) * 128 + (row & 127); }
constexpr int LDS_BYTES = 147456, LDS_BARST = 139264;

typedef float f32x2_t __attribute__((ext_vector_type(2)));
typedef __bf16 bf16x2_t __attribute__((ext_vector_type(2)));
__device__ __forceinline__ unsigned pk2(float lo, float hi) { f32x2_t v = {lo, hi}; bf16x2_t b = __builtin_convertvector(v, bf16x2_t); return __builtin_bit_cast(unsigned, b); }
__device__ __forceinline__ int lane_id_opaque() { int l; asm volatile("v_mbcnt_lo_u32_b32 %0, -1, 0\n\tv_mbcnt_hi_u32_b32 %0, -1, %0" : "=v"(l)); return l; }
__device__ __forceinline__ void lds_barrier() { asm volatile("s_waitcnt lgkmcnt(0)\n\ts_barrier" ::: "memory"); }
__device__ __forceinline__ u32x4 widen16(u32x2 a, u32x2 b) {
    const auto r0 = __builtin_amdgcn_permlane16_swap(a.x, b.x, false, false); const auto r1 = __builtin_amdgcn_permlane16_swap(a.y, b.y, false, false);
    return (u32x4){r0[0], r1[0], r0[1], r1[1]}; }
__device__ __forceinline__ void unwiden16(u32x4 v, u32x2& a, u32x2& b) {
    const auto r0 = __builtin_amdgcn_permlane16_swap(v.x, v.z, false, false); const auto r1 = __builtin_amdgcn_permlane16_swap(v.y, v.w, false, false);
    a = (u32x2){r0[0], r1[0]}; b = (u32x2){r0[1], r1[1]}; }
#define WSEL(k, q) ((k) + ((q) & 1))
#define WOFF(q) (((q) & ~1) * 4)
__device__ __forceinline__ float bflo(unsigned u) { return __builtin_bit_cast(float, u << 16); }
__device__ __forceinline__ float bfhi(unsigned u) { return __builtin_bit_cast(float, u & 0xffff0000u); }
__device__ __forceinline__ float bf2f(bf16_t b) { return __builtin_bit_cast(float, (unsigned)b << 16); }
__device__ __forceinline__ bf16_t f2bf(float f) { return (bf16_t)(pk2(f, 0.f) & 0xffffu); }
__device__ __forceinline__ float siluf(float v) { return v * __builtin_amdgcn_rcpf(1.f + __expf(-v)); }
__device__ __forceinline__ f32x4 mfma16(bf16x8 a, bf16x8 b, f32x4 c) { return __builtin_amdgcn_mfma_f32_16x16x32_bf16(a, b, c, 0, 0, 0); }
__device__ __forceinline__ float wave_sum(float v) {
#pragma unroll
    for (int o = 1; o < 64; o <<= 1) v += __shfl_xor(v, o);
    return v;
}
__device__ __forceinline__ float rstd_from_ssq(const float* ssq, int row) {
    const f32x4* p = (const f32x4*)(ssq + (size_t)row * 16);
    const f32x4 a = p[0], b = p[1], c = p[2], d = p[3];
    const float s = ((a.x + a.y) + (a.z + a.w)) + ((b.x + b.y) + (b.z + b.w)) + ((c.x + c.y) + (c.z + c.w)) + ((d.x + d.y) + (d.z + d.w));
    return rsqrtf(s * (1.f / D) + EPS);
}


typedef __amdgpu_buffer_rsrc_t rsrc_t;
__device__ __forceinline__ rsrc_t ws_rsrc(const void* base) { return __builtin_amdgcn_make_buffer_rsrc((void*)base, (short)0, 0x10000000, 0x00020000); }
__device__ __forceinline__ void st16_wt_nt(rsrc_t r, size_t byte_off, u32x4 v) { __builtin_amdgcn_raw_buffer_store_b128(v, r, (unsigned)byte_off, 0,   18); }
__device__ __forceinline__ void st16_wt(rsrc_t r, size_t byte_off, u32x4 v) { __builtin_amdgcn_raw_buffer_store_b128(v, r, (unsigned)byte_off, 0,   16); }

#define XB_TMO      128
#define XB_XCNT(j)  (256  + 64 * (j))
#define XB_XSUB(j)  (1280 + 64 * (j))
#define XB_XGEN(j)  (2304 + 64 * (j))
#define XB_TOP      3328
#define XB_TOPGEN   3392
#define XCD_BAR_WORDS 3456
#define XB_SPIN_CAP (1u << 18)
__device__ __forceinline__ unsigned xb_ld(unsigned* p)              { return __hip_atomic_load(p, __ATOMIC_RELAXED, __HIP_MEMORY_SCOPE_AGENT); }
__device__ __forceinline__ unsigned xb_add(unsigned* p, unsigned v) { return __hip_atomic_fetch_add(p, v, __ATOMIC_RELAXED, __HIP_MEMORY_SCOPE_AGENT); }
__device__ __forceinline__ unsigned xb_xcc_id() { return (unsigned)__builtin_amdgcn_s_getreg((3 << 11) | 20) & 0xFu; }
#define XB_SPIN(cond, bar) do { unsigned _sp = 0; while (cond) { __builtin_amdgcn_s_sleep(1); \
    if ((++_sp & 255u) == 0u) { if (xb_ld(&(bar)[XB_TMO])) break; if (_sp > XB_SPIN_CAP) { atomicAdd(&(bar)[XB_TMO], 1u); break; } } } } while (0)
struct XcdBarrier { unsigned* bar; unsigned x; volatile LAS unsigned* st; };
__device__ __forceinline__ XcdBarrier xcd_barrier_post(unsigned* bar, volatile LAS unsigned* st) {
    XcdBarrier b; b.bar = bar; b.x = xb_xcc_id(); b.st = st;
    if (threadIdx.x == 0) (void)xb_add(&bar[XB_XCNT(b.x)], 1u);
    return b;
}
__device__ __forceinline__ void xcd_barrier_complete(unsigned* bar, unsigned x, unsigned& nloc, unsigned& nx) {
    const unsigned G = gridDim.x * gridDim.y * gridDim.z;
    unsigned sum, cnt, mine, sp = 0u;
    for (;;) {
        sum = 0u; cnt = 0u; mine = 0u;
#pragma unroll
        for (unsigned j = 0; j < 16; ++j) { const unsigned c = xb_ld(&bar[XB_XCNT(j)]); sum += c; cnt += (c > 0u) ? 1u : 0u; mine = (j == x) ? c : mine; }
        if (sum == G) break;
        __builtin_amdgcn_s_sleep(1);
        if ((++sp & 255u) == 0u) { if (xb_ld(&bar[XB_TMO])) break; if (sp > XB_SPIN_CAP) { atomicAdd(&bar[XB_TMO], 1u); break; } }
    }
    nloc = mine > 0u ? mine : 1u; nx = cnt > 0u ? cnt : 1u;
}
__device__ __forceinline__ void xcd_barrier(const XcdBarrier& b, const bool leader) {
    asm volatile("s_waitcnt vmcnt(0)" ::: "memory");
    __syncthreads();
    if (leader) {
        unsigned* bar = b.bar;
        __builtin_amdgcn_s_waitcnt(0);
        unsigned nloc = b.st[0], nx = b.st[1];
        if (nloc == 0u) { xcd_barrier_complete(bar, b.x, nloc, nx); b.st[0] = nloc; b.st[1] = nx; }
        const unsigned old = xb_add(&bar[XB_XSUB(b.x)], 1u);
        const unsigned gen = old / nloc;
        if (old + 1u == (gen + 1u) * nloc) {
            __builtin_amdgcn_fence(__ATOMIC_RELEASE, "agent");
            asm volatile("s_waitcnt vmcnt(0)" ::: "memory");
            const unsigned og = xb_add(&bar[XB_TOP], 1u);
            const unsigned tg = og / nx;
            if (og + 1u == (tg + 1u) * nx) xb_add(&bar[XB_TOPGEN], 1u);
            else XB_SPIN(xb_ld(&bar[XB_TOPGEN]) == tg, bar);
            __builtin_amdgcn_fence(__ATOMIC_ACQUIRE, "agent");
            xb_add(&bar[XB_XGEN(b.x)], 1u);
            asm volatile("s_waitcnt vmcnt(0)" ::: "memory");
        } else {
            XB_SPIN(xb_ld(&bar[XB_XGEN(b.x)]) == gen, bar);
            __builtin_amdgcn_fence(__ATOMIC_ACQUIRE, "agent");
            asm volatile("s_waitcnt vmcnt(0)" ::: "memory");
        }
    }
    __syncthreads();
}

namespace pg8 {
constexpr int BM = 256, BK = 64, HALF = 128, HTB = HALF * BK * 2, NXCD = 8, WGM = 4;
__host__ __device__ __forceinline__ int lds_byte(int r, int c) { const int st = (r >> 4) * 2 + (c >> 5), rr = r & 15, cc = c & 31, ob = rr * 64 + cc * 2; return st * 1024 + (ob ^ (((ob >> 9) & 1) << 5)); }
__host__ __device__ __forceinline__ void stage_rc(int b, int& R, int& C) { const int st = b / 1024, sb = b % 1024, swz = sb ^ (((sb >> 9) & 1) << 5); R = (st >> 1) * 16 + swz / 64; C = (st & 1) * 32 + (swz % 64) / 2; }
__host__ __device__ __forceinline__ int perm32(int rho) { const int n = rho >> 4, i = rho & 15; return 8 * (i >> 2) + 4 * n + (i & 3); }

struct Unit { int pm, pn; };
struct Gemm { const bf16_t* A; const bf16_t* Bt; int M, N, K, lda, a_pn_off; };

struct StaticOrder {
    int nM, nN, nwg, G, c;
    __host__ __device__ void init(int M_, int N_, int G_, int c_) { nM = M_ / BM; nN = N_ / BM; nwg = nM * nN; G = G_; c = c_; }
    __host__ __device__ bool next(int i, Unit& u) const {
        const long L = (long)i * G + c; if (L >= nwg) return false;
        int wgid = (int)L; { const int q = nwg / NXCD, r = nwg % NXCD, xcd = wgid % NXCD, off = wgid / NXCD; wgid = (xcd < r ? xcd * (q + 1) : r * (q + 1) + (xcd - r) * q) + off; }
        const int nig = WGM * nN, gid = wgid / nig, fm = gid * WGM, gsz = (nM - fm) < WGM ? (nM - fm) : WGM;
        u.pm = fm + ((wgid % nig) % gsz); u.pn = (wgid % nig) / gsz; return true;
    }
};

template <class Epi, bool ALIGN_EPI>
__device__ __forceinline__ void gemm_phase(LAS unsigned char* lds, const Gemm g, const StaticOrder& S, const Epi& E, const int wid) {
    const int lane = lane_id_opaque(), tid = wid * 64 + lane, wr = wid >> 2, wc = wid & 3, fr = lane & 15, fq = lane >> 4;
    const int K = g.K, nt = K / BK;
    unsigned voffA[2], voffB[2];
#pragma unroll
    for (int i = 0; i < 2; ++i) { int R, C; stage_rc(tid * 16 + i * 8192, R, C); const int Rb = (R & ~31) + perm32(R & 31);
        voffA[i] = (unsigned)(R * g.lda + C) * 2u; voffB[i] = (unsigned)(Rb * K + C) * 2u; }
    const size_t kstep = (size_t)(BK * 2);
    const size_t hstepA = (size_t)HALF * g.lda * 2, hstepB = (size_t)HALF * K * 2;
    const size_t tstepA = 2 * hstepA, tstepB = 2 * hstepB;
    const unsigned ldsw = (unsigned)wid * 1024u;
    const int aoff = lds_byte(wr * 64 + fr, fq * 8), boff = lds_byte(wc * 32 + fr, fq * 8);
#define PG8_SA(b, h) (((b) * 2 + (h)) * HTB)
#define PG8_SB(b, h) ((4 + (b) * 2 + (h)) * HTB)
#define PG8_STAGE(bufoff, gbase, voff) do { _Pragma("unroll") for (int _i = 0; _i < 2; ++_i) \
        __builtin_amdgcn_global_load_lds((const unsigned*)((const char*)(gbase) + (voff)[_i]), (LAS unsigned*)(lds + (bufoff) + ldsw + _i * 8192), 16, 0, 0); } while (0)
#define PG8_LDA(dst, b, h) do { _Pragma("unroll") for (int m = 0; m < 4; ++m) _Pragma("unroll") for (int k = 0; k < 2; ++k) dst[m][k] = *(const LAS bf16x8*)(lds + PG8_SA(b, h) + aoff + m * 2048 + k * 1024); } while (0)
#define PG8_LDB(dst, b, h) do { _Pragma("unroll") for (int n = 0; n < 2; ++n) _Pragma("unroll") for (int k = 0; k < 2; ++k) dst[n][k] = *(const LAS bf16x8*)(lds + PG8_SB(b, h) + boff + n * 2048 + k * 1024); } while (0)
#define PG8_MMA(ai, bj, At, Bt) do { __builtin_amdgcn_s_setprio(1); _Pragma("unroll") for (int m = 0; m < 4; ++m) _Pragma("unroll") for (int n = 0; n < 2; ++n) _Pragma("unroll") for (int k = 0; k < 2; ++k) \
        acc[ai][bj][m][n] = __builtin_amdgcn_mfma_f32_16x16x32_bf16(Bt[n][k], At[m][k], acc[ai][bj][m][n], 0, 0, 0); __builtin_amdgcn_s_setprio(0); } while (0)
#define PG8_WAIT_V(n) asm volatile("s_waitcnt vmcnt(" #n ")" ::: "memory")
#define PG8_WAIT_L(n) asm volatile("s_waitcnt lgkmcnt(" #n ")" ::: "memory")
#define PG8_BAR __builtin_amdgcn_s_barrier()
#define PG8_SCHED __builtin_amdgcn_sched_barrier(0)
    Unit cur, nxt; int ui = 0;
    if (!S.next(0, cur)) return;
    f32x4 acc[2][2][4][2];
#pragma unroll
    for (int a = 0; a < 2; ++a)
#pragma unroll
        for (int b = 0; b < 2; ++b)
#pragma unroll
            for (int m = 0; m < 4; ++m)
#pragma unroll
                for (int n = 0; n < 2; ++n) acc[a][b][m][n] = (f32x4){0.f, 0.f, 0.f, 0.f};
    bf16x8 At[4][2], B0[2][2], B1[2][2];
    const char* cA = (const char*)g.A + (size_t)cur.pm * tstepA + (size_t)cur.pn * g.a_pn_off * 2; const char* cB = (const char*)g.Bt + (size_t)cur.pn * tstepB;
    PG8_STAGE(PG8_SB(0, 0), cB, voffB); PG8_STAGE(PG8_SB(0, 1), cB + hstepB, voffB); PG8_STAGE(PG8_SA(0, 0), cA, voffA); PG8_STAGE(PG8_SA(0, 1), cA + hstepA, voffA);
    if (wr == 1) PG8_BAR;
    PG8_WAIT_V(2); PG8_BAR;
    PG8_STAGE(PG8_SB(1, 0), cB + kstep, voffB); PG8_STAGE(PG8_SA(1, 0), cA + kstep, voffA); PG8_STAGE(PG8_SB(1, 1), cB + hstepB + kstep, voffB);
    PG8_WAIT_V(6); PG8_BAR;
    for (;;) {
        const bool has_next = S.next(ui + 1, nxt);
        const char* nA = has_next ? (const char*)g.A + (size_t)nxt.pm * tstepA + (size_t)nxt.pn * g.a_pn_off * 2 : cA; const char* nB = has_next ? (const char*)g.Bt + (size_t)nxt.pn * tstepB : cB;
        for (int t = 0; t < nt; t += 2) {
            const bool last = (t == nt - 2);
            const char* a1 = cA + (size_t)(t + 1) * kstep;
            const char* a2 = last ? nA : cA + (size_t)(t + 2) * kstep; const char* b2 = last ? nB : cB + (size_t)(t + 2) * kstep;
            const char* a3 = a2 + kstep; const char* b3 = b2 + kstep;
            PG8_LDB(B0, 0, 0); PG8_LDB(B1, 0, 1); PG8_SCHED; PG8_LDA(At, 0, 0); PG8_STAGE(PG8_SA(1, 1), a1 + hstepA, voffA);
            PG8_WAIT_V(8); PG8_WAIT_L(0); PG8_BAR; PG8_MMA(0, 0, At, B0); PG8_MMA(0, 1, At, B1); PG8_BAR; PG8_SCHED;
            PG8_LDA(At, 0, 1); PG8_STAGE(PG8_SB(0, 0), b2, voffB); PG8_STAGE(PG8_SB(0, 1), b2 + hstepB, voffB); PG8_STAGE(PG8_SA(0, 0), a2, voffA);
            PG8_WAIT_V(8); PG8_WAIT_L(0); PG8_BAR; PG8_MMA(1, 0, At, B0); PG8_MMA(1, 1, At, B1); PG8_BAR; PG8_SCHED;
            PG8_LDB(B0, 1, 0); PG8_LDB(B1, 1, 1); PG8_SCHED; PG8_LDA(At, 1, 0); PG8_STAGE(PG8_SA(0, 1), a2 + hstepA, voffA);
            PG8_WAIT_V(8); PG8_WAIT_L(0); PG8_BAR; PG8_MMA(0, 0, At, B0); PG8_MMA(0, 1, At, B1); PG8_BAR; PG8_SCHED;
            PG8_LDA(At, 1, 1); PG8_STAGE(PG8_SB(1, 0), b3, voffB); PG8_STAGE(PG8_SB(1, 1), b3 + hstepB, voffB); PG8_STAGE(PG8_SA(1, 0), a3, voffA);
            PG8_WAIT_V(8); PG8_WAIT_L(0); PG8_BAR; PG8_MMA(1, 0, At, B0); PG8_MMA(1, 1, At, B1); PG8_BAR; PG8_SCHED;
        }
        if constexpr (ALIGN_EPI) { if (wr == 0) PG8_BAR; }
        E(acc, cur, wr, wc, fr, fq);
        if (!has_next) break;
#pragma unroll
        for (int a = 0; a < 2; ++a)
#pragma unroll
            for (int b = 0; b < 2; ++b)
#pragma unroll
                for (int m = 0; m < 4; ++m)
#pragma unroll
                    for (int n = 0; n < 2; ++n) acc[a][b][m][n] = (f32x4){0.f, 0.f, 0.f, 0.f};
        cur = nxt; cA = nA; cB = nB; ++ui;
        if constexpr (ALIGN_EPI) { if (wr == 1) PG8_BAR; }
    }
    PG8_WAIT_V(0);
    if constexpr (!ALIGN_EPI) { if (wr == 0) PG8_BAR; }
    PG8_BAR;
#undef PG8_SA
#undef PG8_SB
#undef PG8_STAGE
#undef PG8_LDA
#undef PG8_LDB
#undef PG8_MMA
#undef PG8_WAIT_V
#undef PG8_WAIT_L
#undef PG8_BAR
#undef PG8_SCHED
}

typedef f32x4 Acc[2][2][4][2];

__device__ __forceinline__ void rstd8(const float* ssq, int row0, int fq, float (&rs)[8]) {
    f32x4 part[8];
#pragma unroll
    for (int i = 0; i < 8; ++i) part[i] = *(const f32x4*)(ssq + (size_t)(row0 + (i >> 2) * HALF + (i & 3) * 16) * 16 + fq * 4);
#pragma unroll
    for (int i = 0; i < 8; ++i) { float t = (part[i].x + part[i].y) + (part[i].z + part[i].w); t += __shfl_xor(t, 16); t += __shfl_xor(t, 32); rs[i] = rsqrtf(t * (1.f / D) + EPS); }
}

__device__ __forceinline__ void put_ssq(float* ssq, int row, int pn, int wc, int fq, float ss) {
    ss += __shfl_xor(ss, 16); ss += __shfl_xor(ss, 32);
    if (fq == 0) ssq[(size_t)row * 16 + pn * 4 + wc] = ss;
}

struct EpiPool {
    const float* x; bf16_t* hb; const float* bias; const float* scale; float* ssq;
    __device__ __forceinline__ void operator()(const Acc& acc, const Unit& u, int wr, int wc, int fr, int fq) const {
        const int row0 = u.pm * BM + wr * 64 + fr, col0 = u.pn * BM + wc * 32 + 8 * fq;
#pragma unroll
        for (int ai = 0; ai < 2; ++ai) { f32x4 xq[4][2][2];
#pragma unroll
            for (int m = 0; m < 4; ++m)
#pragma unroll
                for (int bj = 0; bj < 2; ++bj) { const size_t o = (size_t)(row0 + ai * HALF + m * 16) * D + col0 + bj * HALF; xq[m][bj][0] = __builtin_nontemporal_load((const f32x4*)(x + o)); xq[m][bj][1] = __builtin_nontemporal_load((const f32x4*)(x + o + 4)); }
#pragma unroll
            for (int m = 0; m < 4; ++m) { const int row = row0 + ai * HALF + m * 16; float ss = 0.f;
#pragma unroll
                for (int bj = 0; bj < 2; ++bj) { const int c = col0 + bj * HALF; const size_t o = (size_t)row * D + c;
                    const f32x4 x0 = xq[m][bj][0], x1 = xq[m][bj][1];
                    const f32x4 b0 = *(const f32x4*)(bias + c), b1 = *(const f32x4*)(bias + c + 4), s0 = *(const f32x4*)(scale + c), s1 = *(const f32x4*)(scale + c + 4);
                    const f32x4 v0 = x0 + (acc[ai][bj][m][0] + b0) * s0, v1 = x1 + (acc[ai][bj][m][1] + b1) * s1;
                    u32x4 w; w.x = pk2(v0[0], v0[1]); w.y = pk2(v0[2], v0[3]); w.z = pk2(v1[0], v1[1]); w.w = pk2(v1[2], v1[3]);
                    st16_wt(ws_rsrc(hb), o * 2, w);
                    ss += (v0[0] * v0[0] + v0[1] * v0[1]) + (v0[2] * v0[2] + v0[3] * v0[3]) + (v1[0] * v1[0] + v1[1] * v1[1]) + (v1[2] * v1[2] + v1[3] * v1[3]); }
                put_ssq(ssq, row, u.pn, wc, fq, ss); } }
    }
};
struct EpiRes {
    bf16_t* hb; float* ssq;
    __device__ __forceinline__ void operator()(const Acc& acc, const Unit& u, int wr, int wc, int fr, int fq) const {
        const int row0 = u.pm * BM + wr * 64 + fr, col0 = u.pn * BM + wc * 32 + 8 * fq;
        u32x4 hq[2][4][2];
#pragma unroll
        for (int ai = 0; ai < 2; ++ai)
#pragma unroll
            for (int m = 0; m < 4; ++m)
#pragma unroll
                for (int bj = 0; bj < 2; ++bj) hq[ai][m][bj] = *(const u32x4*)(hb + (size_t)(row0 + ai * HALF + m * 16) * D + col0 + bj * HALF);
#pragma unroll
        for (int ai = 0; ai < 2; ++ai)
#pragma unroll
            for (int m = 0; m < 4; ++m) { const int row = row0 + ai * HALF + m * 16; float ss = 0.f;
#pragma unroll
                for (int bj = 0; bj < 2; ++bj) { const size_t o = (size_t)row * D + col0 + bj * HALF;
                    const u32x4 hv = hq[ai][m][bj];
                    const f32x4 v0 = (f32x4){bflo(hv.x), bfhi(hv.x), bflo(hv.y), bfhi(hv.y)} + acc[ai][bj][m][0], v1 = (f32x4){bflo(hv.z), bfhi(hv.z), bflo(hv.w), bfhi(hv.w)} + acc[ai][bj][m][1];
                    u32x4 w; w.x = pk2(v0[0], v0[1]); w.y = pk2(v0[2], v0[3]); w.z = pk2(v1[0], v1[1]); w.w = pk2(v1[2], v1[3]);
                    st16_wt(ws_rsrc(hb), o * 2, w);
                    ss += (v0[0] * v0[0] + v0[1] * v0[1]) + (v0[2] * v0[2] + v0[3] * v0[3]) + (v1[0] * v1[0] + v1[1] * v1[1]) + (v1[2] * v1[2] + v1[3] * v1[3]); }
                put_ssq(ssq, row, u.pn, wc, fq, ss); }
    }
};
struct EpiUp {
    bf16_t* U; const float* ssq;
    __device__ __forceinline__ void operator()(const Acc& acc, const Unit& u, int wr, int wc, int fr, int fq) const {
        const int row0 = u.pm * BM + wr * 64 + fr, col0 = u.pn * BM + wc * 32 + 8 * fq;
        float rs8[8]; rstd8(ssq, row0, fq, rs8);
#pragma unroll
        for (int ai = 0; ai < 2; ++ai)
#pragma unroll
            for (int m = 0; m < 4; ++m) { const int row = row0 + ai * HALF + m * 16; const float rs = rs8[ai * 4 + m];
#pragma unroll
                for (int bj = 0; bj < 2; ++bj) { const size_t o = (size_t)row * FF + col0 + bj * HALF;
                    f32x4 v0 = acc[ai][bj][m][0] * rs, v1 = acc[ai][bj][m][1] * rs;
#pragma unroll
                    for (int j = 0; j < 4; ++j) { const float a = fmaxf(v0[j], 0.f), b = fmaxf(v1[j], 0.f); v0[j] = a * a; v1[j] = b * b; }
                    u32x4 w; w.x = pk2(v0[0], v0[1]); w.y = pk2(v0[2], v0[3]); w.z = pk2(v1[0], v1[1]); w.w = pk2(v1[2], v1[3]);
                    st16_wt(ws_rsrc(U), o * 2, w); } }
    }
};
struct EpiIn {
    bf16_t* ZS; bf16_t* RAWX; bf16_t* RAWBC; const float* ssq;
    __device__ __forceinline__ void operator()(const Acc& acc, const Unit& u, int wr, int wc, int fr, int fq) const {
        const int row0 = u.pm * BM + wr * 64 + fr; const int pn = u.pn;
        bf16_t* base; int ld, ct; bool act = false;
        if (pn < 8) { base = ZS; ld = DI; ct = pn; act = true; } else if (pn < 16) { base = RAWX; ld = DI; ct = pn - 8; } else { base = RAWBC; ld = 1024; ct = pn - 16; }
        const rsrc_t wsr = ws_rsrc(base);
        const int col0 = ct * BM + wc * 32 + 8 * fq;
        float rs8[8]; rstd8(ssq, row0, fq, rs8);
#pragma unroll
        for (int ai = 0; ai < 2; ++ai)
#pragma unroll
            for (int m = 0; m < 4; ++m) { const int row = row0 + ai * HALF + m * 16; const float rs = rs8[ai * 4 + m];
#pragma unroll
                for (int bj = 0; bj < 2; ++bj) { const size_t o = (size_t)row * ld + col0 + bj * HALF;
                    f32x4 v0 = acc[ai][bj][m][0] * rs, v1 = acc[ai][bj][m][1] * rs;
                    if (act) {
#pragma unroll
                        for (int j = 0; j < 4; ++j) { v0[j] = siluf(v0[j]); v1[j] = siluf(v1[j]); } }
                    u32x4 w; w.x = pk2(v0[0], v0[1]); w.y = pk2(v0[2], v0[3]); w.z = pk2(v1[0], v1[1]); w.w = pk2(v1[2], v1[3]);
                    if (act) st16_wt_nt(wsr, o * 2, w); else st16_wt(wsr, o * 2, w); } }
    }
};
}

struct Args {
    const float *x, *norm_mix_g, *norm_mlp_g, *pool_w, *pool_b, *pool_scale, *w_in, *conv_w, *conv_b, *dt_bias, *a_log, *d_skip, *norm_g, *w_out, *w1, *w2, *final_g;
    float* out; unsigned char* ws; int ph_lo, ph_hi;
};

__device__ __forceinline__ void transpose_item(const float* W, int K, int N, const float* gain, bf16_t* WT, int row_off, float* scr, int item, int lane) {
    const int nblk = N / 32, kb = item / nblk, nb = item % nblk, k0 = 64 * kb, n0 = 32 * nb;
    const int kr = lane >> 3, nq = (lane & 7) * 4;
    f32x4 v[8];
#pragma unroll
    for (int i = 0; i < 8; ++i) v[i] = __builtin_nontemporal_load((const f32x4*)(W + (size_t)(k0 + i * 8 + kr) * N + n0 + nq));
#pragma unroll
    for (int i = 0; i < 8; ++i) { const int kk = i * 8 + kr; f32x4 t = v[i]; if (gain) t = t * gain[k0 + kk];
        scr[kk * 33 + nq] = t[0]; scr[kk * 33 + nq + 1] = t[1]; scr[kk * 33 + nq + 2] = t[2]; scr[kk * 33 + nq + 3] = t[3]; }
    __builtin_amdgcn_wave_barrier(); asm volatile("s_waitcnt lgkmcnt(0)" ::: "memory");
    const int c = lane & 7;
#pragma unroll
    for (int j = 0; j < 4; ++j) { const int n = (lane >> 3) + 8 * j; const float* s = scr + (8 * c) * 33 + n;
        u32x4 o; o.x = pk2(s[0 * 33], s[1 * 33]); o.y = pk2(s[2 * 33], s[3 * 33]); o.z = pk2(s[4 * 33], s[5 * 33]); o.w = pk2(s[6 * 33], s[7 * 33]);
        *(u32x4*)(WT + (size_t)(row_off + n0 + n) * K + k0 + 8 * c) = o; }
    __builtin_amdgcn_wave_barrier(); asm volatile("s_waitcnt lgkmcnt(0)" ::: "memory");
}

__device__ __forceinline__ void phase_prologue(unsigned char* lds, const Args& a, const int wave) {
    const int lane = lane_id_opaque(), tid = wave * 64 + lane;
    unsigned char* ws = a.ws;
    {
        float* scr = (float*)(lds + wave * 16384);
        const int gw = blockIdx.x * 8 + wave, NGW = gridDim.x * 8;
        constexpr int I_POOL = 4 * (256 / 64) * (256 / 32), I_W1 = (D / 64) * (FF / 32), I_W2 = (FF / 64) * (D / 32), I_IN = (D / 64) * (INP / 32), I_OUT = (DI / 64) * (D / 32);
        constexpr int NITEMS = I_POOL + 2 * I_W1 + 2 * I_W2 + I_IN + I_OUT;
        for (int it = gw; it < NITEMS; it += NGW) {
            int r = it;
            if (r < I_POOL) { const int g = r / 32; transpose_item(a.pool_w + (size_t)g * 65536, 256, 256, nullptr, (bf16_t*)(ws + W_POOL), g * 256, scr, r % 32, lane); continue; } r -= I_POOL;
            if (r < I_W1) { transpose_item(a.w1, D, FF, a.norm_mlp_g, (bf16_t*)(ws + W_W1_0), 0, scr, r, lane); continue; } r -= I_W1;
            if (r < I_W1) { transpose_item(a.w1 + (size_t)D * FF, D, FF, a.norm_mlp_g + D, (bf16_t*)(ws + W_W1_1), 0, scr, r, lane); continue; } r -= I_W1;
            if (r < I_W2) { transpose_item(a.w2, FF, D, nullptr, (bf16_t*)(ws + W_W2_0), 0, scr, r, lane); continue; } r -= I_W2;
            if (r < I_W2) { transpose_item(a.w2 + (size_t)D * FF, FF, D, nullptr, (bf16_t*)(ws + W_W2_1), 0, scr, r, lane); continue; } r -= I_W2;
            if (r < I_IN) { transpose_item(a.w_in, D, INP, a.norm_mix_g + D, (bf16_t*)(ws + W_IN), 0, scr, r, lane); continue; } r -= I_IN;
            transpose_item(a.w_out, DI, D, a.norm_g, (bf16_t*)(ws + W_OUT), 0, scr, r, lane);
        }
    }
    lds_barrier();
    {
        float* vt = (float*)lds;
        bf16_t* mixed = (bf16_t*)(ws + WS_MIXED);
        for (int tt = blockIdx.x; tt < M / 16; tt += gridDim.x) {
            const int t0 = tt * 16, bpos0 = t0 & (SEQ - 1);
            {
                f32x4 xv[4][4]; bool ok[4];
#pragma unroll
                for (int i = 0; i < 4; ++i) { const int rr = wave + 8 * i; ok[i] = (rr < 31) && (bpos0 - 15 + rr >= 0);
#pragma unroll
                    for (int j = 0; j < 4; ++j) xv[i][j] = ok[i] ? *((const f32x4*)(a.x + (size_t)(t0 - 15 + rr) * D) + 64 * j + lane) : (f32x4){0.f, 0.f, 0.f, 0.f}; }
#pragma unroll
                for (int i = 0; i < 4; ++i) { const int rr = wave + 8 * i;
                    if (rr < 31) { float sq = 0.f;
#pragma unroll
                        for (int j = 0; j < 4; ++j) sq += (xv[i][j].x * xv[i][j].x + xv[i][j].y * xv[i][j].y) + (xv[i][j].z * xv[i][j].z + xv[i][j].w * xv[i][j].w);
                        const float rs = rsqrtf(wave_sum(sq) * (1.f / D) + EPS);
#pragma unroll
                        for (int j = 0; j < 4; ++j) *((f32x4*)(vt + rr * D) + 64 * j + lane) = xv[i][j] * rs; } }
            }
            lds_barrier();
            {
                const int cq = tid & 255, th = tid >> 8, tl = th * 8, gi = cq >> 6, w = 2 << gi;
                const f32x4 g4 = *(const f32x4*)(a.norm_mix_g + cq * 4);
                f32x4 sacc = {0.f, 0.f, 0.f, 0.f};
                const int jstart = tl - (w - 1);
                for (int j = jstart; j < tl + 8; ++j) {
                    const f32x4 v = *(const f32x4*)(vt + (j + 15) * D + cq * 4);
                    sacc += v;
                    const int jo = j - w;
                    if (jo >= jstart) sacc -= *(const f32x4*)(vt + (jo + 15) * D + cq * 4);
                    if (j >= tl) { const int pos = bpos0 + j; const int cnt = (pos + 1 < w) ? pos + 1 : w; const float ic = 1.f / (float)cnt;
                        const f32x4 mx = (sacc * ic - v) * g4;
                        u32x2 o; o.x = pk2(mx[0], mx[1]); o.y = pk2(mx[2], mx[3]);
                        *(u32x2*)(mixed + (size_t)(t0 + j) * D + cq * 4) = o; }
                }
            }
            lds_barrier();
        }
    }
}

__device__ __forceinline__ void phase_dt(unsigned char* lds, const Args& a, const int wave) {
    const int lane = lane_id_opaque(), tid = wave * 64 + lane, fr = lane & 15, q = lane >> 4;
    constexpr int WP = 1032;
    bf16_t* Wl = (bf16_t*)lds;
    {
        const bf16_t* Wg = (const bf16_t*)(a.ws + W_IN) + (size_t)NMAIN * D;
#pragma unroll
        for (int i = 0; i < 8; ++i) { const int idx = tid + i * 512, row = idx >> 7, ch = (idx & 127) * 8; *(u32x4*)(Wl + row * WP + ch) = *(const u32x4*)(Wg + (size_t)row * D + ch); }
    }
    lds_barrier();
    float* DT = (float*)(a.ws + WS_DT);
    for (int it = blockIdx.x * 8 + wave; it < 2 * (M / 16); it += gridDim.x * 8) {
        const int row0 = (it >> 1) * 16, nt = it & 1;
        const bf16_t* Ag = (const bf16_t*)(a.ws + WS_HB) + (size_t)(row0 + fr) * D + q * 8;
        const bf16_t* Bl = Wl + (nt * 16 + fr) * WP + q * 8;
        f32x4 acc = {0.f, 0.f, 0.f, 0.f};
#pragma unroll
        for (int k0 = 0; k0 < 32; k0 += 16) { bf16x8 av[16];
#pragma unroll
            for (int i = 0; i < 16; ++i) av[i] = *(const bf16x8*)(Ag + (k0 + i) * 32);
#pragma unroll
            for (int i = 0; i < 16; ++i) acc = mfma16(av[i], *(const bf16x8*)(Bl + (k0 + i) * 32), acc); }
        const float bb = a.dt_bias[nt * 16 + fr];
#pragma unroll
        for (int r = 0; r < 4; ++r) { const int row = row0 + q * 4 + r; const float rs = rstd_from_ssq((const float*)(a.ws + WS_SSQ), row);
            const float v = acc[r] * rs + bb; DT[dti(row, nt * 16 + fr)] = v > 20.f ? v : log1pf(__expf(v)); }
    }
}

constexpr int LP = 136;
__device__ __forceinline__ void phase_bc(unsigned char* lds, const Args& a, const int wave) {
    const int lane = lane_id_opaque(), tid = wave * 64 + lane, fr = lane & 15, q = lane >> 4;
    bf16_t* Bs = (bf16_t*)lds; bf16_t* Cs = Bs + 128 * LP; bf16_t* BsT = Cs + 128 * LP; float* acs8 = (float*)(BsT + 128 * LP); float* dt8 = acs8 + 1024; float* cwl = dt8 + 1024;
    const bf16_t* RAWBC = (const bf16_t*)(a.ws + WS_RAWBC); const bf16_t* RAWX = (const bf16_t*)(a.ws + WS_RAWX);
    const float* DT = (const float*)(a.ws + WS_DT); float* ACS = (float*)(a.ws + WS_ACS);
    for (int unit = blockIdx.x; unit < 512; unit += gridDim.x) {
        const int g = unit & 3, bc = unit >> 2, c = bc & 31, b = bc >> 5;
        const int t0 = b * SEQ + c * 128;
        const size_t tile = (size_t)unit * 16384;
        bf16_t* CB = (bf16_t*)(a.ws + WS_CB) + tile;
        bf16_t* ST = (bf16_t*)a.out + (size_t)unit * 8 * 8192;
        {
            const int cg8 = tid & 31, rg = tid >> 5; const bool isC = cg8 >= 16; const int n0 = (cg8 & 15) * 8;
            const int col = (isC ? 512 : 0) + g * 128 + n0;
            float cw[4][8], cbv[8];
#pragma unroll
            for (int k = 0; k < 4; ++k) { const f32x4 w0 = *(const f32x4*)(a.conv_w + (size_t)k * 3072 + 2048 + col), w1 = *(const f32x4*)(a.conv_w + (size_t)k * 3072 + 2048 + col + 4);
#pragma unroll
                for (int j = 0; j < 4; ++j) { cw[k][j] = w0[j]; cw[k][4 + j] = w1[j]; } }
            { const f32x4 b0 = *(const f32x4*)(a.conv_b + 2048 + col), b1 = *(const f32x4*)(a.conv_b + 2048 + col + 4);
#pragma unroll
              for (int j = 0; j < 4; ++j) { cbv[j] = b0[j]; cbv[4 + j] = b1[j]; } }
            float xr[11][8];
#pragma unroll
            for (int i = 0; i < 11; ++i) { const int row = rg * 8 - 3 + i; const bool zr_ = (c == 0 && row < 0);
                u32x4 v = __builtin_nontemporal_load((const u32x4*)(RAWBC + (size_t)(t0 + (zr_ ? 0 : row)) * 1024 + col)); if (zr_) v = (u32x4){0u, 0u, 0u, 0u};
                xr[i][0] = bflo(v.x); xr[i][1] = bfhi(v.x); xr[i][2] = bflo(v.y); xr[i][3] = bfhi(v.y); xr[i][4] = bflo(v.z); xr[i][5] = bfhi(v.z); xr[i][6] = bflo(v.w); xr[i][7] = bfhi(v.w); }
            bf16_t* dst = isC ? Cs : Bs;
#pragma unroll
            for (int i = 0; i < 8; ++i) { float o[8];
#pragma unroll
                for (int j = 0; j < 8; ++j) o[j] = siluf(cbv[j] + cw[0][j] * xr[i][j] + cw[1][j] * xr[i + 1][j] + cw[2][j] * xr[i + 2][j] + cw[3][j] * xr[i + 3][j]);
                u32x4 w; w.x = pk2(o[0], o[1]); w.y = pk2(o[2], o[3]); w.z = pk2(o[4], o[5]); w.w = pk2(o[6], o[7]);
                *(u32x4*)(dst + (rg * 8 + i) * LP + n0) = w; }
        }
        {
            const int h = g * 8 + wave; const float av = -__expf(a.a_log[h]);
            const f32x2_t dd_ = *(const f32x2_t*)(DT + dti(t0, h) + 2 * lane); const float d0 = dd_.x, d1 = dd_.y;
            const float v0 = d0 * av, v1 = d1 * av;
            float s = v0 + v1;
#pragma unroll
            for (int o = 1; o < 64; o <<= 1) { const float t = __shfl_up(s, o); if (lane >= o) s += t; }
            *(f32x2_t*)(ACS + dti(t0, h) + 2 * lane) = (f32x2_t){s - v1, s};
#pragma unroll
            for (int k = 0; k < 4; ++k) cwl[k * 512 + tid] = a.conv_w[(size_t)k * 3072 + g * 512 + tid];
            cwl[4 * 512 + tid] = a.conv_b[g * 512 + tid];
            acs8[wave * 128 + 2 * lane] = s - v1; acs8[wave * 128 + 2 * lane + 1] = s; dt8[wave * 128 + 2 * lane] = d0; dt8[wave * 128 + 2 * lane + 1] = d1;
        }
        lds_barrier();
        {
            const int n = tid & 127, lg = tid >> 7;
#pragma unroll
            for (int i = 0; i < 4; ++i) { const int l0 = lg * 32 + i * 8; const bf16_t* sp_ = Bs + l0 * LP + n;
                u32x4 w; w.x = (unsigned)sp_[0] | ((unsigned)sp_[LP] << 16); w.y = (unsigned)sp_[2 * LP] | ((unsigned)sp_[3 * LP] << 16); w.z = (unsigned)sp_[4 * LP] | ((unsigned)sp_[5 * LP] << 16); w.w = (unsigned)sp_[6 * LP] | ((unsigned)sp_[7 * LP] << 16);
                *(u32x4*)(BsT + n * LP + l0) = w; }
        }
        {
            bf16x8 cf[4];
#pragma unroll
            for (int kk = 0; kk < 4; ++kk) cf[kk] = *(const bf16x8*)(Cs + (16 * wave + fr) * LP + kk * 32 + q * 8);
            __builtin_amdgcn_s_setprio(1);
#pragma unroll
            for (int st = 0; st < 8; st += 2) { u32x2 o2[2];
#pragma unroll
                for (int e = 0; e < 2; ++e) { f32x4 acc = {0.f, 0.f, 0.f, 0.f};
#pragma unroll
                    for (int kk = 0; kk < 4; ++kk) { const bf16x8 bfm = *(const bf16x8*)(Bs + (16 * (st + e) + fr) * LP + kk * 32 + q * 8); acc = mfma16(bfm, cf[kk], acc); }
                    o2[e].x = pk2(acc[0], acc[1]); o2[e].y = pk2(acc[2], acc[3]); }
                *(u32x4*)(CB + (16 * wave + fr) * 128 + 16 * WSEL(st, q) + WOFF(q)) = widen16(o2[0], o2[1]); }
            __builtin_amdgcn_s_setprio(0);
        }
        lds_barrier();
        {
            bf16x8 bt[4];
#pragma unroll
            for (int kk = 0; kk < 4; ++kk) bt[kk] = *(const bf16x8*)(BsT + (16 * wave + fr) * LP + kk * 32 + q * 8);
            const int s0 = (wave * 8 + (lane >> 3)) * 2, p0 = (lane & 7) * 8;
            u32x4 xq[5];
#pragma unroll
            for (int i = 0; i < 5; ++i) { const int row = s0 - 3 + i; const bool zr_ = (c == 0 && row < 0); const u32x4 v_ = __builtin_nontemporal_load((const u32x4*)(RAWX + (size_t)(t0 + (zr_ ? 0 : row)) * DI + (g * 8) * 64 + p0)); xq[i] = zr_ ? (u32x4){0u, 0u, 0u, 0u} : v_; }
            for (int hh = 0; hh < 8; ++hh) {
                const int ch0 = (g * 8 + hh) * 64 + p0;
                bf16_t* xe = (hh & 1) ? Cs : Bs;
                {
                    float cw[4][8], cbv[8];
#pragma unroll
                    for (int k = 0; k < 5; ++k) { const f32x4 w0 = *(const f32x4*)(cwl + k * 512 + hh * 64 + p0), w1 = *(const f32x4*)(cwl + k * 512 + hh * 64 + p0 + 4);
#pragma unroll
                        for (int j = 0; j < 4; ++j) { if (k < 4) { cw[k][j] = w0[j]; cw[k][4 + j] = w1[j]; } else { cbv[j] = w0[j]; cbv[4 + j] = w1[j]; } } }
                    float xr[5][8];
#pragma unroll
                    for (int i = 0; i < 5; ++i) { const u32x4 v = xq[i];
                        xr[i][0] = bflo(v.x); xr[i][1] = bfhi(v.x); xr[i][2] = bflo(v.y); xr[i][3] = bfhi(v.y); xr[i][4] = bflo(v.z); xr[i][5] = bfhi(v.z); xr[i][6] = bflo(v.w); xr[i][7] = bfhi(v.w); }
                    const float acL = acs8[hh * 128 + 127];
                    const float e0 = dt8[hh * 128 + s0] * __expf(acL - acs8[hh * 128 + s0]), e1 = dt8[hh * 128 + s0 + 1] * __expf(acL - acs8[hh * 128 + s0 + 1]);
#pragma unroll
                    for (int j = 0; j < 8; ++j) {
                        const float x0 = siluf(cbv[j] + cw[0][j] * xr[0][j] + cw[1][j] * xr[1][j] + cw[2][j] * xr[2][j] + cw[3][j] * xr[3][j]);
                        const float x1 = siluf(cbv[j] + cw[0][j] * xr[1][j] + cw[1][j] * xr[2][j] + cw[2][j] * xr[3][j] + cw[3][j] * xr[4][j]);
                        *(unsigned*)(xe + (p0 + j) * LP + s0) = pk2(x0 * e0, x1 * e1); }
                }
                if (hh + 1 < 8) {
#pragma unroll
                    for (int i = 0; i < 5; ++i) { const int row = s0 - 3 + i; const bool zr_ = (c == 0 && row < 0); const u32x4 v_ = __builtin_nontemporal_load((const u32x4*)(RAWX + (size_t)(t0 + (zr_ ? 0 : row)) * DI + ch0 + 64)); xq[i] = zr_ ? (u32x4){0u, 0u, 0u, 0u} : v_; } }
                lds_barrier();
                bf16_t* STh = ST + (size_t)hh * 8192;
                __builtin_amdgcn_s_setprio(1);
#pragma unroll
                for (int mt = 0; mt < 4; mt += 2) { u32x2 o2[2];
#pragma unroll
                    for (int e = 0; e < 2; ++e) { f32x4 acc = {0.f, 0.f, 0.f, 0.f};
#pragma unroll
                        for (int kk = 0; kk < 4; ++kk) { const bf16x8 xo = *(const bf16x8*)(xe + ((mt + e) * 16 + fr) * LP + kk * 32 + q * 8); acc = mfma16(bt[kk], xo, acc); }
                        o2[e].x = pk2(acc[0], acc[1]); o2[e].y = pk2(acc[2], acc[3]); }
                    *(u32x4*)(STh + (WSEL(mt, q) * 16 + fr) * 128 + 16 * wave + WOFF(q)) = widen16(o2[0], o2[1]); }
                __builtin_amdgcn_s_setprio(0);
            }
        }
        lds_barrier();
    }
}

__device__ __forceinline__ void phase_scan(const Args& a, const int wave) {
    const int lane = lane_id_opaque(), tid = wave * 64 + lane;
    const float* ACS = (const float*)(a.ws + WS_ACS);
    for (int gid = blockIdx.x * 512 + tid; gid < 128 * 1024; gid += gridDim.x * 512) {
        const int bh = gid >> 10, b = bh >> 5, h = bh & 31, e = (gid & 1023) * 8;
        float prev[8];
#pragma unroll
        for (int j = 0; j < 8; ++j) prev[j] = 0.f;
        for (int c0 = 0; c0 < 32; c0 += 8) {
            u32x4 sv[8]; float cd[8];
#pragma unroll
            for (int i = 0; i < 8; ++i) { const int c = c0 + i; sv[i] = __builtin_nontemporal_load((const u32x4*)((const bf16_t*)a.out + (size_t)((b * 32 + c) * 32 + h) * 8192 + e)); cd[i] = ACS[dti(b * SEQ + c * 128 + 127, h)]; }
#pragma unroll
            for (int i = 0; i < 8; ++i) { const int c = c0 + i; const float d = __expf(cd[i]);
                u32x4 o; o.x = pk2(prev[0], prev[1]); o.y = pk2(prev[2], prev[3]); o.z = pk2(prev[4], prev[5]); o.w = pk2(prev[6], prev[7]);
                *(u32x4*)((bf16_t*)a.out + (size_t)((b * 32 + c) * 32 + h) * 8192 + e) = o;
                const u32x4 v = sv[i];
                prev[0] = prev[0] * d + bflo(v.x); prev[1] = prev[1] * d + bfhi(v.x); prev[2] = prev[2] * d + bflo(v.y); prev[3] = prev[3] * d + bfhi(v.y);
                prev[4] = prev[4] * d + bflo(v.z); prev[5] = prev[5] * d + bfhi(v.z); prev[6] = prev[6] * d + bflo(v.w); prev[7] = prev[7] * d + bfhi(v.w); }
        }
    }
}

__device__ __forceinline__ void phase_y(unsigned char* lds, const Args& a, const int w, const bool do_store = true) {
    const int lane = lane_id_opaque(), tid = w * 64 + lane, fr = lane & 15, q = lane >> 4;
    bf16_t* Cs = (bf16_t*)lds; bf16_t* xd0 = Cs + 128 * LP; bf16_t* xd1 = xd0 + 64 * LP; bf16_t* pvs0 = xd1 + 64 * LP; bf16_t* pvs1 = pvs0 + 64 * LP; float* acs8 = (float*)(pvs1 + 64 * LP); float* dt8 = acs8 + 1024; float* cwl = dt8 + 1024; float* ddl = cwl + 2560;
    const bf16_t* RAWBC = (const bf16_t*)(a.ws + WS_RAWBC); const bf16_t* RAWX = (const bf16_t*)(a.ws + WS_RAWX); bf16_t* ZS = (bf16_t*)(a.ws + WS_ZS);
    const float* DT = (const float*)(a.ws + WS_DT); const float* ACS = (const float*)(a.ws + WS_ACS);
    for (int unit = blockIdx.x; unit < 512; unit += gridDim.x) {
        const int g = unit & 3, bc = unit >> 2, c = bc & 31, b = bc >> 5;
        const int t0 = b * SEQ + c * 128;
        const bf16_t* CB = (const bf16_t*)(a.ws + WS_CB) + (size_t)unit * 16384;
        const bf16_t* PV = (const bf16_t*)a.out + (size_t)unit * 8 * 8192;
        {
            const int n0 = (tid & 15) * 8, rg = tid >> 4; const int col = 512 + g * 128 + n0;
            float cw[4][8], cbv[8];
#pragma unroll
            for (int k = 0; k < 4; ++k) { const f32x4 w0 = *(const f32x4*)(a.conv_w + (size_t)k * 3072 + 2048 + col), w1 = *(const f32x4*)(a.conv_w + (size_t)k * 3072 + 2048 + col + 4);
#pragma unroll
                for (int j = 0; j < 4; ++j) { cw[k][j] = w0[j]; cw[k][4 + j] = w1[j]; } }
            { const f32x4 b0 = *(const f32x4*)(a.conv_b + 2048 + col), b1 = *(const f32x4*)(a.conv_b + 2048 + col + 4);
#pragma unroll
              for (int j = 0; j < 4; ++j) { cbv[j] = b0[j]; cbv[4 + j] = b1[j]; } }
            float xr[7][8];
#pragma unroll
            for (int i = 0; i < 7; ++i) { const int row = rg * 4 - 3 + i; const bool zr_ = (c == 0 && row < 0);
                u32x4 v = __builtin_nontemporal_load((const u32x4*)(RAWBC + (size_t)(t0 + (zr_ ? 0 : row)) * 1024 + col)); if (zr_) v = (u32x4){0u, 0u, 0u, 0u};
                xr[i][0] = bflo(v.x); xr[i][1] = bfhi(v.x); xr[i][2] = bflo(v.y); xr[i][3] = bfhi(v.y); xr[i][4] = bflo(v.z); xr[i][5] = bfhi(v.z); xr[i][6] = bflo(v.w); xr[i][7] = bfhi(v.w); }
#pragma unroll
            for (int i = 0; i < 4; ++i) { float o[8];
#pragma unroll
                for (int j = 0; j < 8; ++j) o[j] = siluf(cbv[j] + cw[0][j] * xr[i][j] + cw[1][j] * xr[i + 1][j] + cw[2][j] * xr[i + 2][j] + cw[3][j] * xr[i + 3][j]);
                u32x4 wv; wv.x = pk2(o[0], o[1]); wv.y = pk2(o[2], o[3]); wv.z = pk2(o[4], o[5]); wv.w = pk2(o[6], o[7]);
                *(u32x4*)(Cs + (rg * 4 + i) * LP + n0) = wv; }
        }
#pragma unroll
        for (int k = 0; k < 4; ++k) cwl[k * 512 + tid] = a.conv_w[(size_t)k * 3072 + g * 512 + tid];
        cwl[4 * 512 + tid] = a.conv_b[g * 512 + tid];
        { const int h = g * 8 + w;
          *(f32x2_t*)(acs8 + w * 128 + 2 * lane) = *(const f32x2_t*)(ACS + dti(t0, h) + 2 * lane);
          const f32x2_t dv_ = *(const f32x2_t*)(DT + dti(t0, h) + 2 * lane); *(f32x2_t*)(dt8 + w * 128 + 2 * lane) = dv_;
          const float dk_ = a.d_skip[h]; *(f32x2_t*)(ddl + w * 128 + 2 * lane) = (f32x2_t){dk_ / dv_.x, dk_ / dv_.y}; }
        lds_barrier();
        const int l = 16 * w + fr;
        bf16x8 aC[4]; u32x4 cbr[4];
#pragma unroll
        for (int kk = 0; kk < 4; ++kk) { aC[kk] = *(const bf16x8*)(Cs + l * LP + kk * 32 + q * 8); cbr[kk] = __builtin_nontemporal_load((const u32x4*)(CB + l * 128 + kk * 32 + q * 8)); }
        const int s0 = (w * 8 + (lane >> 3)) * 2, p0 = (lane & 7) * 8;
        u32x4 xq[5];
#pragma unroll
        for (int i = 0; i < 5; ++i) { const int row = s0 - 3 + i; const bool zr_ = (c == 0 && row < 0); const u32x4 v_ = __builtin_nontemporal_load((const u32x4*)(RAWX + (size_t)(t0 + (zr_ ? 0 : row)) * DI + (g * 8) * 64 + p0)); xq[i] = zr_ ? (u32x4){0u, 0u, 0u, 0u} : v_; }
        u32x4 pq[2], zw[2];
        const int pvr = tid >> 3, pvc = (tid & 7) * 16;
#define Y_LOAD_P(hx) do { const bf16_t* src_ = PV + (size_t)(hx) * 8192 + pvr * 128 + pvc; pq[0] = __builtin_nontemporal_load((const u32x4*)src_); pq[1] = __builtin_nontemporal_load((const u32x4*)(src_ + 8)); } while (0)
#define Y_LOAD_Z(hx) do { _Pragma("unroll") for (int pr = 0; pr < 2; ++pr) zw[pr] = *(const u32x4*)(ZS + (size_t)(t0 + l) * DI + (g * 8 + (hx)) * 64 + WSEL(2 * pr, q) * 16 + WOFF(q)); } while (0)
        Y_LOAD_P(0); Y_LOAD_Z(0);
        float gss = 0.f;
        for (int hh = 0; hh < 8; ++hh) {
            const int h = g * 8 + hh, ch0 = h * 64 + p0;
            bf16_t* xd = (hh & 1) ? xd1 : xd0; bf16_t* pvs = (hh & 1) ? pvs1 : pvs0;
            *(u32x4*)(pvs + pvr * LP + pvc) = pq[0]; *(u32x4*)(pvs + pvr * LP + pvc + 8) = pq[1];
            {
                float cw[4][8], cbv[8];
#pragma unroll
                for (int k = 0; k < 5; ++k) { const f32x4 w0 = *(const f32x4*)(cwl + k * 512 + hh * 64 + p0), w1 = *(const f32x4*)(cwl + k * 512 + hh * 64 + p0 + 4);
#pragma unroll
                    for (int j = 0; j < 4; ++j) { if (k < 4) { cw[k][j] = w0[j]; cw[k][4 + j] = w1[j]; } else { cbv[j] = w0[j]; cbv[4 + j] = w1[j]; } } }
                float xr[5][8];
#pragma unroll
                for (int i = 0; i < 5; ++i) { const u32x4 v = xq[i];
                    xr[i][0] = bflo(v.x); xr[i][1] = bfhi(v.x); xr[i][2] = bflo(v.y); xr[i][3] = bfhi(v.y); xr[i][4] = bflo(v.z); xr[i][5] = bfhi(v.z); xr[i][6] = bflo(v.w); xr[i][7] = bfhi(v.w); }
                const float dt0 = dt8[hh * 128 + s0], dt1 = dt8[hh * 128 + s0 + 1];
#pragma unroll
                for (int j = 0; j < 8; ++j) {
                    const float x0 = siluf(cbv[j] + cw[0][j] * xr[0][j] + cw[1][j] * xr[1][j] + cw[2][j] * xr[2][j] + cw[3][j] * xr[3][j]);
                    const float x1 = siluf(cbv[j] + cw[0][j] * xr[1][j] + cw[1][j] * xr[2][j] + cw[2][j] * xr[3][j] + cw[3][j] * xr[4][j]);
                    *(unsigned*)(xd + (p0 + j) * LP + s0) = pk2(x0 * dt0, x1 * dt1); }
            }
            if (hh + 1 < 8) {
#pragma unroll
                for (int i = 0; i < 5; ++i) { const int row = s0 - 3 + i; const bool zr_ = (c == 0 && row < 0); const u32x4 v_ = __builtin_nontemporal_load((const u32x4*)(RAWX + (size_t)(t0 + (zr_ ? 0 : row)) * DI + ch0 + 64)); xq[i] = zr_ ? (u32x4){0u, 0u, 0u, 0u} : v_; } }
            lds_barrier();
            if (hh + 1 < 8) Y_LOAD_P(hh + 1);
            __builtin_amdgcn_s_setprio(1);
            bf16x8 aS[4];
            const float al = acs8[hh * 128 + l], dd = ddl[hh * 128 + l];
#pragma unroll
            for (int kk = 0; kk < 4; ++kk) { aS[kk] = (bf16x8){0, 0, 0, 0, 0, 0, 0, 0};
                if (kk * 32 <= 16 * w + 15) {
                    const u32x4 raw = cbr[kk];
                    float cv[8] = {bflo(raw.x), bfhi(raw.x), bflo(raw.y), bfhi(raw.y), bflo(raw.z), bfhi(raw.z), bflo(raw.w), bfhi(raw.w)};
                    const int sb = kk * 32 + q * 8;
#pragma unroll
                    for (int j = 0; j < 8; ++j) { const int s = sb + j; float v = (s <= l) ? cv[j] * __expf(al - acs8[hh * 128 + s]) : 0.f; if (s == l) v += dd; cv[j] = v; }
                    u32x4 pk; pk.x = pk2(cv[0], cv[1]); pk.y = pk2(cv[2], cv[3]); pk.z = pk2(cv[4], cv[5]); pk.w = pk2(cv[6], cv[7]);
                    aS[kk] = __builtin_bit_cast(bf16x8, pk); } }
            const float eo = __expf(al); float ss = 0.f;
            u32x2 zq[4], oo[4]; unwiden16(zw[0], zq[0], zq[1]); unwiden16(zw[1], zq[2], zq[3]);
#pragma unroll
            for (int mt = 0; mt < 4; ++mt) { f32x4 accO = {0.f, 0.f, 0.f, 0.f}, accD = {0.f, 0.f, 0.f, 0.f};
#pragma unroll
                for (int kk = 0; kk < 4; ++kk) { const bf16x8 po = *(const bf16x8*)(pvs + (mt * 16 + fr) * LP + kk * 32 + q * 8); accO = mfma16(po, aC[kk], accO); }
#pragma unroll
                for (int kk = 0; kk < 4; ++kk) if (kk * 32 <= 16 * w + 15) { const bf16x8 xo = *(const bf16x8*)(xd + (mt * 16 + fr) * LP + kk * 32 + q * 8); accD = mfma16(xo, aS[kk], accD); }
                const u32x2 z = zq[mt];
                const float y0 = (accD[0] + eo * accO[0]) * bflo(z.x), y1 = (accD[1] + eo * accO[1]) * bfhi(z.x), y2 = (accD[2] + eo * accO[2]) * bflo(z.y), y3 = (accD[3] + eo * accO[3]) * bfhi(z.y);
                oo[mt].x = pk2(y0, y1); oo[mt].y = pk2(y2, y3);
                ss += (y0 * y0 + y1 * y1) + (y2 * y2 + y3 * y3); }
#pragma unroll
            for (int pr = 0; pr < 2; ++pr) { const u32x4 wv = widen16(oo[2 * pr], oo[2 * pr + 1]);
                if (do_store) *(u32x4*)(ZS + (size_t)(t0 + l) * DI + h * 64 + WSEL(2 * pr, q) * 16 + WOFF(q)) = wv; }
            __builtin_amdgcn_s_setprio(0);
            gss += ss;
            if (hh + 1 < 8) Y_LOAD_Z(hh + 1);
        }
#undef Y_LOAD_P
#undef Y_LOAD_Z
        gss += __shfl_xor(gss, 16); gss += __shfl_xor(gss, 32);
        {
            const float rs = rsqrtf(gss * (1.f / 512.f) + EPS);
#pragma unroll 2
            for (int hh = 0; hh < 8; ++hh)
#pragma unroll
                for (int pr = 0; pr < 2; ++pr) { const int col = (g * 8 + hh) * 64 + WSEL(2 * pr, q) * 16 + WOFF(q);
                    u32x4* p = (u32x4*)(ZS + (size_t)(t0 + l) * DI + col); const u32x4 v = *p;
                    u32x4 o; o.x = pk2(bflo(v.x) * rs, bfhi(v.x) * rs); o.y = pk2(bflo(v.y) * rs, bfhi(v.y) * rs); o.z = pk2(bflo(v.z) * rs, bfhi(v.z) * rs); o.w = pk2(bflo(v.w) * rs, bfhi(v.w) * rs);
                    if (do_store) *p = o; }
        }
        lds_barrier();
    }
}

__device__ __forceinline__ void phase_final(const Args& a, const int wave) {
    const int lane = lane_id_opaque();
    const bf16_t* hb = (const bf16_t*)(a.ws + WS_HB);
    for (int row = blockIdx.x * 8 + wave; row < M; row += gridDim.x * 8) {
        const float rs = rstd_from_ssq((const float*)(a.ws + WS_SSQ), row);
        f32x4* p = (f32x4*)(a.out + (size_t)row * D);
#pragma unroll
        for (int j = 0; j < 2; ++j) { const int c = j * 512 + lane * 8; const u32x4 hv = __builtin_nontemporal_load((const u32x4*)(hb + (size_t)row * D + c));
            const f32x4 g0 = *(const f32x4*)(a.final_g + c), g1 = *(const f32x4*)(a.final_g + c + 4);
            __builtin_nontemporal_store((f32x4){bflo(hv.x), bfhi(hv.x), bflo(hv.y), bfhi(hv.y)} * rs * g0, &p[c / 4]); __builtin_nontemporal_store((f32x4){bflo(hv.z), bfhi(hv.z), bflo(hv.w), bfhi(hv.w)} * rs * g1, &p[c / 4 + 1]); }
    }
}

constexpr int NPHASE = 12;
typedef const __attribute__((address_space(4))) Args* KArgsPtr;
#define LOADARGS const Args a = *(const Args*)kp; unsigned char* ws = a.ws; float* ssq = (float*)(ws + WS_SSQ); bf16_t* hb = (bf16_t*)(ws + WS_HB); bf16_t* U = (bf16_t*)(ws + WS_U); (void)ssq; (void)hb; (void)U
__global__ void __launch_bounds__(512, 2) fwd_megakernel(Args a_unused) {
    extern __shared__ __attribute__((aligned(16))) unsigned char lds[];
    cg::grid_group grid = cg::this_grid();
    KArgsPtr kp = (KArgsPtr)__builtin_amdgcn_kernarg_segment_ptr();
    LAS unsigned char* l3 = (LAS unsigned char*)lds;
    const int G = gridDim.x, bx = blockIdx.x;
#define IN(k) (kp->ph_lo <= (k) && (k) < kp->ph_hi)
    const int wid_s = __builtin_amdgcn_readfirstlane(threadIdx.x >> 6);
    volatile LAS unsigned* barst = (volatile LAS unsigned*)(l3 + LDS_BARST);
    if (threadIdx.x < 2) barst[threadIdx.x] = 0u;
    __syncthreads();
    (void)xcd_barrier_post((unsigned*)(kp->ws + WS_BAR), barst);
    if (kp->ph_lo < 0) grid.sync();
#define SEAM(k) do { if (IN(k) && IN((k) + 1)) { { XcdBarrier xb_; xb_.bar = (unsigned*)(kp->ws + WS_BAR); xb_.x = xb_xcc_id(); xb_.st = (volatile LAS unsigned*)(l3 + LDS_BARST); xcd_barrier(xb_, wid_s == 0 && lane_id_opaque() == 0); } } } while (0)

    if (IN(0)) { LOADARGS; phase_prologue(lds, a, wid_s); } SEAM(0);
    if (IN(1)) { LOADARGS; pg8::Gemm g{(const bf16_t*)(ws + WS_MIXED), (const bf16_t*)(ws + W_POOL), M, D, 256, D, 256}; pg8::StaticOrder S; S.init(M, D, G, bx);
        pg8::EpiPool E{a.x, hb, a.pool_b, a.pool_scale, ssq}; pg8::gemm_phase<pg8::EpiPool, true>(l3, g, S, E, wid_s); } SEAM(1);
    if (IN(2)) { LOADARGS; pg8::Gemm g{hb, (const bf16_t*)(ws + W_W1_0), M, FF, D, D, 0}; pg8::StaticOrder S; S.init(M, FF, G, bx);
        pg8::EpiUp E{U, ssq}; pg8::gemm_phase<pg8::EpiUp, true>(l3, g, S, E, wid_s); } SEAM(2);
    if (IN(3)) { LOADARGS; pg8::Gemm g{U, (const bf16_t*)(ws + W_W2_0), M, D, FF, FF, 0}; pg8::StaticOrder S; S.init(M, D, G, bx);
        pg8::EpiRes E{hb, ssq}; pg8::gemm_phase<pg8::EpiRes, true>(l3, g, S, E, wid_s); } SEAM(3);
    if (IN(4)) { LOADARGS; pg8::Gemm g{hb, (const bf16_t*)(ws + W_IN), M, NMAIN, D, D, 0}; pg8::StaticOrder S; S.init(M, NMAIN, G, bx);
        pg8::EpiIn E{(bf16_t*)(ws + WS_ZS), (bf16_t*)(ws + WS_RAWX), (bf16_t*)(ws + WS_RAWBC), ssq}; phase_dt(lds, a, wid_s); lds_barrier();
        pg8::gemm_phase<pg8::EpiIn, true>(l3, g, S, E, wid_s); } SEAM(4);
    if (IN(5)) { LOADARGS;
        phase_bc(lds, a, wid_s); } SEAM(5);
    if (IN(6)) { LOADARGS; phase_scan(a, wid_s); } SEAM(6);
    if (IN(7)) { LOADARGS;
        phase_y(lds, a, wid_s); } SEAM(7);
    if (IN(8)) { LOADARGS; pg8::Gemm g{(const bf16_t*)(ws + WS_ZS), (const bf16_t*)(ws + W_OUT), M, D, DI, DI, 0}; pg8::StaticOrder S; S.init(M, D, G, bx);
        pg8::EpiRes E{hb, ssq}; pg8::gemm_phase<pg8::EpiRes, true>(l3, g, S, E, wid_s); } SEAM(8);
    if (IN(9)) { LOADARGS; pg8::Gemm g{hb, (const bf16_t*)(ws + W_W1_1), M, FF, D, D, 0}; pg8::StaticOrder S; S.init(M, FF, G, bx);
        pg8::EpiUp E{U, ssq}; pg8::gemm_phase<pg8::EpiUp, true>(l3, g, S, E, wid_s); } SEAM(9);
    if (IN(10)) { LOADARGS; pg8::Gemm g{U, (const bf16_t*)(ws + W_W2_1), M, D, FF, FF, 0}; pg8::StaticOrder S; S.init(M, D, G, bx);
        pg8::EpiRes E{hb, ssq}; pg8::gemm_phase<pg8::EpiRes, true>(l3, g, S, E, wid_s); } SEAM(10);
    if (IN(11)) { LOADARGS; phase_final(a, wid_s); }
#undef IN
#undef SEAM
}

extern "C" void kernel_launch(void* const* d_in, const int* in_sizes, int n_in, void* d_out, int out_size, void* d_ws, size_t ws_size, hipStream_t stream) {
    static int grid = 0;
    if (grid == 0) {
        if (n_in != 17 || in_sizes[0] != M * D || out_size != M * D || ws_size < WS_END) { fprintf(stderr, "kernel_launch: unexpected shapes (n_in %d, in0 %d, out %d, ws %zu)\n", n_in, n_in > 0 ? in_sizes[0] : -1, out_size, ws_size); grid = -1; return; }
        int dev = 0, cus = 0, per_cu = 0;
        hipGetDevice(&dev); hipDeviceGetAttribute(&cus, hipDeviceAttributeMultiprocessorCount, dev);
        if (hipFuncSetAttribute((const void*)fwd_megakernel, hipFuncAttributeMaxDynamicSharedMemorySize, LDS_BYTES) != hipSuccess) { fprintf(stderr, "kernel_launch: hipFuncSetAttribute failed\n"); grid = -1; return; }
        if (hipOccupancyMaxActiveBlocksPerMultiprocessor(&per_cu, (const void*)fwd_megakernel, 512, LDS_BYTES) != hipSuccess || per_cu < 1) { fprintf(stderr, "kernel_launch: occupancy query says %d\n", per_cu); per_cu = 1; (void)hipGetLastError(); }
        grid = cus * (per_cu > 1 ? 1 : per_cu);
        if (grid > 256) grid = 256;
    }
    if (grid < 0) return;
    if (hipMemsetAsync((unsigned char*)d_ws + WS_BAR, 0, 16384, stream) != hipSuccess) { fprintf(stderr, "kernel_launch: memset of the barrier words failed\n"); return; }
    Args a{};
    a.x = (const float*)d_in[0]; a.norm_mix_g = (const float*)d_in[1]; a.norm_mlp_g = (const float*)d_in[2]; a.pool_w = (const float*)d_in[3]; a.pool_b = (const float*)d_in[4];
    a.pool_scale = (const float*)d_in[5]; a.w_in = (const float*)d_in[6]; a.conv_w = (const float*)d_in[7]; a.conv_b = (const float*)d_in[8]; a.dt_bias = (const float*)d_in[9];
    a.a_log = (const float*)d_in[10]; a.d_skip = (const float*)d_in[11]; a.norm_g = (const float*)d_in[12]; a.w_out = (const float*)d_in[13]; a.w1 = (const float*)d_in[14];
    a.w2 = (const float*)d_in[15]; a.final_g = (const float*)d_in[16]; a.out = (float*)d_out; a.ws = (unsigned char*)d_ws;
#if MK_PER_PHASE
    for (int p = 0; p < NPHASE; ++p) { if (!((MK_PHASE_MASK >> p) & 1)) continue; a.ph_lo = p; a.ph_hi = p + 1; void* args[] = {&a};
        hipError_t e = hipLaunchCooperativeKernel((const void*)fwd_megakernel, dim3(grid), dim3(512), args, LDS_BYTES, stream);
        if (e != hipSuccess) { fprintf(stderr, "launch %d failed: %s\n", p, hipGetErrorString(e)); break; } }
#else
    a.ph_lo = 0; a.ph_hi = NPHASE; void* args[] = {&a};
    hipError_t e = hipLaunchCooperativeKernel((const void*)fwd_megakernel, dim3(grid), dim3(512), args, LDS_BYTES, stream);
    if (e != hipSuccess) fprintf(stderr, "cooperative launch failed: %s (grid %d)\n", hipGetErrorString(e), grid);
#endif
}
```
